# Optimizing an MI355X kernel written in HIP

```python
import jax
import jax.numpy as jnp
from jax import lax
import numpy as np


D_MODEL = 1024
BATCH = 8
SEQ = 2048
DEPTH = 4

GRID_W = 64
CTX_LEN = 256
N_MIXERS = 3
N_HEADS = 16
N_KV_HEADS = 4
HEAD_DIM = D_MODEL // N_HEADS
Q_GROUP = N_HEADS // N_KV_HEADS
ROPE_FREQS = HEAD_DIM // 4
ROPE_THETA = 10000.0
Q_BLOCK = 128
CONV_WIDTH = 31
D_RNN = D_MODEL
N_LRU_BLOCKS = 4
LRU_BLOCK = D_RNN // N_LRU_BLOCKS
LRU_CONV_WIDTH = 4
LRU_C = 8.0
D_FF = 4 * D_MODEL
EPS = 1e-6
N_A = (DEPTH + N_MIXERS - 1) // N_MIXERS
N_B = (DEPTH + N_MIXERS - 2) // N_MIXERS
N_C = (DEPTH + N_MIXERS - 3) // N_MIXERS

kernel_name = 'hybrid_interleaved_dit_block'

F32 = jnp.float32


def _rms_f32(x, g):
    xf = x.astype(F32)
    return xf * lax.rsqrt(jnp.mean(xf * xf, axis=-1, keepdims=True) + EPS) * g.astype(F32)


def rms_norm(x, g):
    return _rms_f32(x, g).astype(x.dtype)


def layer_norm(x, g, b):
    xf = x.astype(F32)
    xc = xf - jnp.mean(xf, axis=-1, keepdims=True)
    var = jnp.mean(xc * xc, axis=-1, keepdims=True)
    return (xc * lax.rsqrt(var + EPS) * g.astype(F32) + b.astype(F32)).astype(x.dtype)


def ada_mod(cond, w, b):
    m = jax.nn.silu(cond) @ w + b
    return jnp.split(m[:, None, :], 6, axis=-1)


def modulate(h, shift, scale):
    return h * (1.0 + scale) + shift


def depthwise_conv(x, w, b, pad):
    y = lax.conv_general_dilated(x, w[:, None, :].astype(x.dtype), window_strides=(1,), padding=[pad],
                                 dimension_numbers=('NWC', 'WIO', 'NWC'), feature_group_count=x.shape[-1])
    return y + b


def axial_rope_tables(n_tokens):
    rows = n_tokens // GRID_W
    row = jnp.repeat(jnp.arange(rows, dtype=jnp.int32), GRID_W)
    col = jnp.tile(jnp.arange(GRID_W, dtype=jnp.int32), rows)
    pos = jnp.stack([row, col], axis=-1).astype(F32)
    inv = ROPE_THETA ** (-jnp.arange(ROPE_FREQS, dtype=F32) / ROPE_FREQS)
    ang = pos[:, :, None] * inv
    return jnp.cos(ang), jnp.sin(ang)


def apply_axial_rope(x, cos, sin):
    b, n, h, _ = x.shape
    xr = x.reshape(b, n, h, 2, 2, ROPE_FREQS)
    x1, x2 = xr[..., 0, :], xr[..., 1, :]
    cs, sn = cos[None, :, None], sin[None, :, None]
    out = jnp.stack([x1 * cs - x2 * sn, x1 * sn + x2 * cs], axis=-2)
    return out.reshape(b, n, h, HEAD_DIM)


def gqa_attend(q, k, v):
    b, nq = q.shape[:2]
    qg = q.reshape(b, nq, N_KV_HEADS, Q_GROUP, HEAD_DIM)
    s = jnp.einsum('bqkgd,btkd->bkgqt', qg, k) * (HEAD_DIM ** -0.5)
    p = jax.nn.softmax(s, axis=-1)
    o = jnp.einsum('bkgqt,btkd->bqkgd', p, v)
    return o.reshape(b, nq, N_HEADS * HEAD_DIM)


def attention_mixer(h_lat, h_ctx, w_qkv, q_gain, k_gain, w_o, need_ctx):
    bsz, n_lat, _ = h_lat.shape
    hq = N_HEADS * HEAD_DIM
    hkv = N_KV_HEADS * HEAD_DIM

    def heads_q(q):
        return _rms_f32(q.reshape(q.shape[0], q.shape[1], N_HEADS, HEAD_DIM), q_gain)

    def heads_kv(kv):
        k, v = kv[..., :hkv], kv[..., hkv:]
        k = _rms_f32(k.reshape(k.shape[0], k.shape[1], N_KV_HEADS, HEAD_DIM), k_gain)
        v = v.reshape(v.shape[0], v.shape[1], N_KV_HEADS, HEAD_DIM).astype(F32)
        return k, v

    qkv_l = h_lat @ w_qkv
    q_l = heads_q(qkv_l[..., :hq])
    k_l, v_l = heads_kv(qkv_l[..., hq:])
    k_c, v_c = heads_kv(h_ctx @ w_qkv[:, hq:])
    cos, sin = axial_rope_tables(n_lat)
    q_l = apply_axial_rope(q_l, cos, sin)
    k_l = apply_axial_rope(k_l, cos, sin)
    k_all = jnp.concatenate([k_c, k_l], axis=1)
    v_all = jnp.concatenate([v_c, v_l], axis=1)
    n_blk = n_lat // Q_BLOCK
    q_blk = q_l.reshape(bsz, n_blk, Q_BLOCK, N_HEADS, HEAD_DIM).transpose(1, 0, 2, 3, 4)
    o_blk = lax.map(lambda qb: gqa_attend(qb, k_all, v_all), q_blk)
    o_l = o_blk.transpose(1, 0, 2, 3).reshape(bsz, n_lat, hq).astype(h_lat.dtype)
    out_l = o_l @ w_o
    if not need_ctx:
        return out_l, None
    q_c = heads_q(h_ctx @ w_qkv[:, :hq])
    o_c = gqa_attend(q_c, k_c, v_c).astype(h_ctx.dtype)
    return out_l, o_c @ w_o


def conformer_mixer(h_lat, h_ctx, w_in, b_in, w_dw, b_dw, n_g, n_b, w_out, b_out, need_ctx):
    half = CONV_WIDTH // 2

    def conv_module(h):
        u = h @ w_in + b_in
        a, g = u[..., :D_MODEL], u[..., D_MODEL:]
        u = a * jax.nn.sigmoid(g)
        u = depthwise_conv(u, w_dw, b_dw, (half, half))
        u = jax.nn.silu(layer_norm(u, n_g, n_b))
        return u @ w_out + b_out

    out_l = conv_module(h_lat)
    if not need_ctx:
        return out_l, None
    return out_l, conv_module(h_ctx)


def _linear_combine(e1, e2):
    a1, b1 = e1
    a2, b2 = e2
    return a1 * a2, a2 * b1 + b2


def rglru_scan(u, gate_w, gate_b, lam, h0):
    bsz, n, _ = u.shape
    ub = u.reshape(bsz, n, N_LRU_BLOCKS, LRU_BLOCK)
    gates = jnp.einsum('blnd,gnde->gblne', ub, gate_w).reshape(2, bsz, n, D_RNN) + gate_b[:, None, None, :]
    gates = jax.nn.sigmoid(gates.astype(F32))
    r, i = gates[0], gates[1]
    log_a = -LRU_C * r * jax.nn.softplus(-lam.astype(F32))
    a = jnp.exp(log_a)
    mult = jnp.sqrt(-jnp.expm1(2.0 * log_a))
    if h0 is None:
        mult = mult.at[:, 0].set(1.0)
    b = mult * i * u.astype(F32)
    a_cum, b_cum = lax.associative_scan(_linear_combine, (a, b), axis=1)
    if h0 is None:
        return b_cum
    return a_cum * h0[:, None, :] + b_cum


def rglru_direction(x_c, x_l, conv_w, conv_b, gate_w, gate_b, lam):
    pad = (LRU_CONV_WIDTH - 1, 0)
    h_c = rglru_scan(depthwise_conv(x_c, conv_w, conv_b, pad), gate_w, gate_b, lam, None)
    h_l = rglru_scan(depthwise_conv(x_l, conv_w, conv_b, pad), gate_w, gate_b, lam, h_c[:, -1])
    return h_l, h_c


def recurrent_mixer(h_lat, h_ctx, w_in, conv_w, conv_b, gate_w, gate_b, lam, w_out, need_ctx):
    gx_l = h_lat @ w_in
    g_l = jax.nn.gelu(gx_l[..., :D_RNN].astype(F32))
    x_l = gx_l[..., D_RNN:]
    if need_ctx:
        gx_c = h_ctx @ w_in
        g_c = jax.nn.gelu(gx_c[..., :D_RNN].astype(F32))
        x_c = gx_c[..., D_RNN:]
    else:
        x_c = h_ctx @ w_in[:, D_RNN:]
    hf_l, hf_c = rglru_direction(x_c, x_l, conv_w[0], conv_b[0], gate_w[0], gate_b[0], lam[0])
    hb_l, hb_c = rglru_direction(x_c[:, ::-1], x_l[:, ::-1], conv_w[1], conv_b[1], gate_w[1], gate_b[1], lam[1])
    y_l = ((hf_l + hb_l[:, ::-1]) * g_l).astype(h_lat.dtype)
    out_l = y_l @ w_out
    if not need_ctx:
        return out_l, None
    y_c = ((hf_c + hb_c[:, ::-1]) * g_c).astype(h_ctx.dtype)
    return out_l, y_c @ w_out


def sq_relu_mlp(h, w1, w2):
    return jnp.square(jax.nn.relu(h @ w1)) @ w2


def setup_inputs(seed: int = 0) -> dict:
    key = jax.random.key(seed)
    ks = iter(jax.random.split(key, 40))

    def nrm(shape, s):
        return jax.random.normal(next(ks), shape, F32) * s

    def gain(shape):
        return 1.0 + nrm(shape, 0.02)

    hq = N_HEADS * HEAD_DIM
    hkv = N_KV_HEADS * HEAD_DIM
    inp = {}
    inp['x'] = nrm((BATCH, SEQ, D_MODEL), 1.0)
    inp['c'] = nrm((BATCH, D_MODEL), 1.0)
    inp['ctx'] = nrm((BATCH, CTX_LEN, D_MODEL), 1.0)
    inp['c_ctx'] = nrm((D_MODEL,), 1.0)
    inp['mod_w'] = nrm((DEPTH, D_MODEL, 6 * D_MODEL), 0.3 * D_MODEL ** -0.5)
    inp['mod_b'] = nrm((DEPTH, 6 * D_MODEL), 0.01)
    inp['norm_mix_g'] = gain((DEPTH, D_MODEL))
    inp['norm_mlp_g'] = gain((DEPTH, D_MODEL))
    inp['mlp_w1'] = nrm((DEPTH, D_MODEL, D_FF), D_MODEL ** -0.5)
    inp['mlp_w2'] = nrm((DEPTH, D_FF, D_MODEL), D_FF ** -0.5)
    inp['attn_w_qkv'] = nrm((N_A, D_MODEL, hq + 2 * hkv), D_MODEL ** -0.5)
    inp['attn_q_gain'] = gain((N_A, HEAD_DIM))
    inp['attn_k_gain'] = gain((N_A, HEAD_DIM))
    inp['attn_w_o'] = nrm((N_A, hq, D_MODEL), hq ** -0.5)
    inp['conv_w_in'] = nrm((N_B, D_MODEL, 2 * D_MODEL), D_MODEL ** -0.5)
    inp['conv_b_in'] = nrm((N_B, 2 * D_MODEL), 0.02)
    inp['conv_w_dw'] = nrm((N_B, CONV_WIDTH, D_MODEL), CONV_WIDTH ** -0.5)
    inp['conv_b_dw'] = nrm((N_B, D_MODEL), 0.02)
    inp['conv_norm_g'] = gain((N_B, D_MODEL))
    inp['conv_norm_b'] = nrm((N_B, D_MODEL), 0.02)
    inp['conv_w_out'] = nrm((N_B, D_MODEL, D_MODEL), D_MODEL ** -0.5)
    inp['conv_b_out'] = nrm((N_B, D_MODEL), 0.02)
    inp['lru_w_in'] = nrm((N_C, D_MODEL, 2 * D_RNN), D_MODEL ** -0.5)
    inp['lru_conv_w'] = nrm((N_C, 2, LRU_CONV_WIDTH, D_RNN), LRU_CONV_WIDTH ** -0.5)
    inp['lru_conv_b'] = nrm((N_C, 2, D_RNN), 0.02)
    inp['lru_gate_w'] = nrm((N_C, 2, 2, N_LRU_BLOCKS, LRU_BLOCK, LRU_BLOCK), LRU_BLOCK ** -0.5)
    inp['lru_gate_b'] = nrm((N_C, 2, 2, D_RNN), 0.02)
    a8 = jax.random.uniform(next(ks), (N_C, 2, D_RNN), F32, 0.9, 0.999)
    a0 = a8 ** (1.0 / LRU_C)
    inp['lru_lambda'] = jnp.log(a0) - jnp.log1p(-a0)
    inp['lru_w_out'] = nrm((N_C, D_RNN, D_MODEL), D_RNN ** -0.5)
    return inp


def reference(x, c, ctx, c_ctx, mod_w, mod_b, norm_mix_g, norm_mlp_g, mlp_w1, mlp_w2,
              attn_w_qkv, attn_q_gain, attn_k_gain, attn_w_o,
              conv_w_in, conv_b_in, conv_w_dw, conv_b_dw, conv_norm_g, conv_norm_b, conv_w_out, conv_b_out,
              lru_w_in, lru_conv_w, lru_conv_b, lru_gate_w, lru_gate_b, lru_lambda, lru_w_out):
    x_lat, x_ctx = x, ctx
    cond_ctx = c_ctx[None, :]
    for i in range(DEPTH):
        kind = i % N_MIXERS
        j = i // N_MIXERS
        need_ctx = i < DEPTH - 1
        sh1, sc1, g1, sh2, sc2, g2 = ada_mod(c, mod_w[i], mod_b[i])
        csh1, csc1, cg1, csh2, csc2, cg2 = ada_mod(cond_ctx, mod_w[i], mod_b[i])
        h_l = modulate(rms_norm(x_lat, norm_mix_g[i]), sh1, sc1)
        h_c = modulate(rms_norm(x_ctx, norm_mix_g[i]), csh1, csc1)
        if kind == 0:
            out_l, out_c = attention_mixer(h_l, h_c, attn_w_qkv[j], attn_q_gain[j], attn_k_gain[j],
                                           attn_w_o[j], need_ctx)
        elif kind == 1:
            out_l, out_c = conformer_mixer(h_l, h_c, conv_w_in[j], conv_b_in[j], conv_w_dw[j], conv_b_dw[j],
                                           conv_norm_g[j], conv_norm_b[j], conv_w_out[j], conv_b_out[j], need_ctx)
        else:
            out_l, out_c = recurrent_mixer(h_l, h_c, lru_w_in[j], lru_conv_w[j], lru_conv_b[j], lru_gate_w[j],
                                           lru_gate_b[j], lru_lambda[j], lru_w_out[j], need_ctx)
        x_lat = x_lat + g1 * out_l
        x_lat = x_lat + g2 * sq_relu_mlp(modulate(rms_norm(x_lat, norm_mlp_g[i]), sh2, sc2), mlp_w1[i], mlp_w2[i])
        if need_ctx:
            x_ctx = x_ctx + cg1 * out_c
            x_ctx = x_ctx + cg2 * sq_relu_mlp(modulate(rms_norm(x_ctx, norm_mlp_g[i]), csh2, csc2),
                                              mlp_w1[i], mlp_w2[i])
    return x_lat
```

```cpp
#include <hip/hip_runtime.h>
#include <cstdint>
#include <cstdio>

constexpr int D = 1024, BATCH = 8, SEQ = 2048, CTXL = 256, DEPTH = 4;
constexpr int ML = BATCH * SEQ, MC = BATCH * CTXL, M = ML + MC;
constexpr int NH = 16, NKV = 4, HD = 64, TKV = CTXL + SEQ;
constexpr int DFF = 4096;
constexpr float EPS = 1e-6f;
constexpr float QSCALE = 0.125f * 1.4426950408889634f;

typedef unsigned short bf16_t;
__device__ __forceinline__ float bf2f(bf16_t v) { return __uint_as_float((unsigned)v << 16); }
__device__ __forceinline__ bf16_t f2bf(float f) { unsigned u = __float_as_uint(f); return (bf16_t)((u + 0x7fffu + ((u >> 16) & 1u)) >> 16); }

__device__ __forceinline__ int row_bidx(int r) { return r < ML ? (r >> 11) : 8; }
__device__ __forceinline__ int row_batch(int r) { return r < ML ? (r >> 11) : ((r - ML) >> 8); }
__device__ __forceinline__ int row_tok(int r) { return r < ML ? (r & 2047) : ((r - ML) & 255); }
__device__ __forceinline__ int row_len(int r) { return r < ML ? SEQ : CTXL; }
__device__ __forceinline__ int kv_row(int r) { return row_batch(r) * TKV + (r < ML ? CTXL : 0) + row_tok(r); }

constexpr size_t MiB = 1u << 20;
constexpr size_t OFF_CTL = 0, OFF_MODF = 1 * MiB, OFF_SW = 2 * MiB, OFF_GAIN = 3 * MiB, OFF_TAB = 3 * MiB + 512 * 1024, OFF_SSQ = 4 * MiB;
constexpr size_t OFF_XC = 6 * MiB, OFF_WT = 14 * MiB, OFF_XG = 102 * MiB, OFF_R1 = 138 * MiB, OFF_R2 = 174 * MiB, OFF_BIG = 210 * MiB, OFF_KV = 354 * MiB, WS_END = 372 * MiB;

struct XPtr { float* xl; float* xc; __device__ __forceinline__ float* row(int r) const { return r < ML ? xl + (size_t)r * D : xc + (size_t)(r - ML) * D; } };

__global__ void k_mod(const float* c, const float* c_ctx, const float* mod_w, const float* mod_b, float* MODF) {
    const int idx = blockIdx.x * 256 + threadIdx.x;
    const int n = idx % 6144, bi = (idx / 6144) % 9, l = idx / (6144 * 9);
    const float* cond = bi < 8 ? c + bi * D : c_ctx;
    const float* w = mod_w + (size_t)l * D * 6144 + n;
    float acc = 0.f;
    for (int k = 0; k < D; ++k) { const float x = cond[k]; const float s = x / (1.f + expf(-x)); acc += s * w[(size_t)k * 6144]; }
    MODF[idx] = acc + mod_b[l * 6144 + n];
}
__global__ void k_init(const float* x, const float* ctx, XPtr X) {
    const size_t i = (size_t)blockIdx.x * 256 + threadIdx.x;
    const size_t nl = (size_t)ML * D / 4;
    if (i < nl) ((float4*)X.xl)[i] = ((const float4*)x)[i]; else ((float4*)X.xc)[i - nl] = ((const float4*)ctx)[i - nl];
}
__device__ __forceinline__ float block_sum256(float v, float* red) {
    for (int o = 32; o > 0; o >>= 1) v += __shfl_xor(v, o);
    __syncthreads();
    if ((threadIdx.x & 63) == 0) red[threadIdx.x >> 6] = v;
    __syncthreads();
    return red[0] + red[1] + red[2] + red[3];
}
__global__ void k_normmod(XPtr X, const float* g, const float* MODF_l, int sec, float* HN) {
    __shared__ float red[4];
    const int row = blockIdx.x, tid = threadIdx.x, bi = row_bidx(row);
    const float4 v = ((const float4*)X.row(row))[tid];
    const float ss = block_sum256(v.x * v.x + v.y * v.y + v.z * v.z + v.w * v.w, red);
    const float rstd = rsqrtf(ss * (1.f / D) + EPS);
    const float4 gg = ((const float4*)g)[tid];
    const float4 sh = ((const float4*)(MODF_l + (size_t)bi * 6144 + sec * D))[tid];
    const float4 sc = ((const float4*)(MODF_l + (size_t)bi * 6144 + (sec + 1) * D))[tid];
    float4 o;
    o.x = v.x * rstd * gg.x * (1.f + sc.x) + sh.x; o.y = v.y * rstd * gg.y * (1.f + sc.y) + sh.y;
    o.z = v.z * rstd * gg.z * (1.f + sc.z) + sh.z; o.w = v.w * rstd * gg.w * (1.f + sc.w) + sh.w;
    ((float4*)(HN + (size_t)row * D))[tid] = o;
}

__device__ __forceinline__ float ldA(const float* p) { return *p; }
__device__ __forceinline__ float ldA(const bf16_t* p) { return bf2f(*p); }
template <typename AT, class EPI>
__global__ void __launch_bounds__(256) naive_gemm(const AT* A, int lda, const float* W, int ldw, int K, EPI epi) {
    __shared__ float As[16][68], Bs[16][68];
    const int tid = threadIdx.x, tx = tid & 15, ty = tid >> 4;
    const int m0 = blockIdx.y * 64, n0 = blockIdx.x * 64;
    float acc[4][4] = {};
    for (int k0 = 0; k0 < K; k0 += 16) {
        { const int r = tid >> 2, kk = (tid & 3) * 4; const AT* ap = A + (size_t)(m0 + r) * lda + k0 + kk;
#pragma unroll
          for (int i = 0; i < 4; ++i) As[kk + i][r] = ldA(ap + i); }
        { const int kk = tid >> 4, c = (tid & 15) * 4; const float4 b = *(const float4*)(W + (size_t)(k0 + kk) * ldw + n0 + c);
          Bs[kk][c] = b.x; Bs[kk][c + 1] = b.y; Bs[kk][c + 2] = b.z; Bs[kk][c + 3] = b.w; }
        __syncthreads();
#pragma unroll
        for (int kk = 0; kk < 16; ++kk) {
            float a[4], b[4];
#pragma unroll
            for (int i = 0; i < 4; ++i) { a[i] = As[kk][ty * 4 + i]; b[i] = Bs[kk][tx * 4 + i]; }
#pragma unroll
            for (int i = 0; i < 4; ++i)
#pragma unroll
                for (int j = 0; j < 4; ++j) acc[i][j] += a[i] * b[j];
        }
        __syncthreads();
    }
#pragma unroll
    for (int i = 0; i < 4; ++i)
#pragma unroll
        for (int j = 0; j < 4; ++j) epi(m0 + ty * 4 + i, n0 + tx * 4 + j, acc[i][j]);
}
struct EpiStoreF32 { float* C; int ldc; const float* bias; __device__ __forceinline__ void operator()(int r, int c, float v) const { C[(size_t)r * ldc + c] = v + (bias ? bias[c] : 0.f); } };
struct EpiStoreBf16 { bf16_t* C; int ldc; const float* bias; __device__ __forceinline__ void operator()(int r, int c, float v) const { C[(size_t)r * ldc + c] = f2bf(v + (bias ? bias[c] : 0.f)); } };
struct EpiRelu2 { bf16_t* H; __device__ __forceinline__ void operator()(int r, int c, float v) const { const float t = v > 0.f ? v : 0.f; H[(size_t)r * DFF + c] = f2bf(t * t); } };
struct EpiResid { XPtr X; const float* gate  ; const float* bias;
    __device__ __forceinline__ void operator()(int r, int c, float v) const { float* x = X.row(r) + c; *x += gate[(size_t)row_bidx(r) * 6144 + c] * (v + (bias ? bias[c] : 0.f)); } };

__global__ void k_qkv_post(const float* TMP, const float* qg, const float* kg, bf16_t* Q, bf16_t* Kb, bf16_t* Vb) {
    const int idx = blockIdx.x * 4 + (threadIdx.x >> 6), d = threadIdx.x & 63;
    const int row = idx / 24, s = idx % 24;
    float v = TMP[(size_t)row * 1536 + s * 64 + d];
    if (s < 20) {
        float ss = v * v;
        for (int o = 32; o > 0; o >>= 1) ss += __shfl_xor(ss, o);
        v = v * rsqrtf(ss * (1.f / 64.f) + EPS) * (s < 16 ? qg : kg)[d];
        const float other = __shfl_xor(v, 16);
        if (row < ML) {
            const int t = row_tok(row), a = d >> 5, f = d & 15;
            const float pos = (float)(a == 0 ? (t >> 6) : (t & 63));
            const float inv = powf(10000.f, -(float)f / 16.f), ang = pos * inv, cs = cosf(ang), sn = sinf(ang);
            v = (d & 16) ? (other * sn + v * cs) : (v * cs - other * sn);
        }
    }
    if (s < 16) Q[(size_t)row * D + s * 64 + d] = f2bf(v * QSCALE);
    else (s < 20 ? Kb : Vb)[(size_t)kv_row(row) * 256 + (s & 3) * 64 + d] = f2bf(v);
}
__global__ void __launch_bounds__(256) k_attn_naive(const bf16_t* Q, const bf16_t* Kb, const bf16_t* Vb, bf16_t* O, int nrows) {
    const int idx = blockIdx.x * 256 + threadIdx.x;
    const int h = idx / nrows, row = idx % nrows;
    const int b = row_batch(row), nk = row < ML ? TKV : CTXL, kvh = h >> 2;
    float q[64], o[64];
#pragma unroll
    for (int d = 0; d < 64; ++d) { q[d] = bf2f(Q[(size_t)row * D + h * 64 + d]); o[d] = 0.f; }
    float m = -1e30f, l = 0.f;
    for (int j = 0; j < nk; ++j) {
        const bf16_t* kp = Kb + (size_t)(b * TKV + j) * 256 + kvh * 64;
        const bf16_t* vp = Vb + (size_t)(b * TKV + j) * 256 + kvh * 64;
        float s = 0.f;
#pragma unroll
        for (int d = 0; d < 64; ++d) s += q[d] * bf2f(kp[d]);
        const float mn = fmaxf(m, s), corr = exp2f(m - mn), p = exp2f(s - mn);
        l = l * corr + p; m = mn;
#pragma unroll
        for (int d = 0; d < 64; ++d) o[d] = o[d] * corr + p * bf2f(vp[d]);
    }
    const float il = 1.f / l;
#pragma unroll
    for (int d = 0; d < 64; ++d) O[(size_t)row * D + h * 64 + d] = f2bf(o[d] * il);
}
__global__ void k_glu_post(const float* TMP, bf16_t* U) {
    const size_t i = (size_t)blockIdx.x * 256 + threadIdx.x;
    const size_t row = i / D; const int c = (int)(i % D);
    const float a = TMP[row * 2048 + c], g = TMP[row * 2048 + 1024 + c];
    U[i] = f2bf(a / (1.f + expf(-g)));
}
__global__ void k_conv31_naive(const bf16_t* U, const float* w_dw, const float* b_dw, const float* n_g, const float* n_b, bf16_t* Y) {
    __shared__ float red[4];
    const int row = blockIdx.x, tid = threadIdx.x, c0 = tid * 4;
    const int t = row_tok(row), L = row_len(row), base = row - t;
    float v[4];
#pragma unroll
    for (int i = 0; i < 4; ++i) v[i] = b_dw[c0 + i];
    for (int k = 0; k < 31; ++k) { const int tt = t + k - 15; if (tt < 0 || tt >= L) continue;
        const bf16_t* u = U + (size_t)(base + tt) * D + c0;
#pragma unroll
        for (int i = 0; i < 4; ++i) v[i] += w_dw[k * D + c0 + i] * bf2f(u[i]); }
    const float mean = block_sum256(v[0] + v[1] + v[2] + v[3], red) * (1.f / D);
    float q = 0.f;
#pragma unroll
    for (int i = 0; i < 4; ++i) { v[i] -= mean; q += v[i] * v[i]; }
    const float rstd = rsqrtf(block_sum256(q, red) * (1.f / D) + EPS);
#pragma unroll
    for (int i = 0; i < 4; ++i) { const float y = v[i] * rstd * n_g[c0 + i] + n_b[c0 + i]; Y[(size_t)row * D + c0 + i] = f2bf(y / (1.f + expf(-y))); }
}
__global__ void k_lruin_post(const float* TMP, bf16_t* G, bf16_t* XB) {
    const size_t i = (size_t)blockIdx.x * 256 + threadIdx.x;
    const size_t row = i / D; const int c = (int)(i % D);
    const float x = TMP[row * 2048 + c];
    G[i] = f2bf(0.5f * x * (1.f + tanhf(0.7978845608028654f * (x + 0.044715f * x * x * x))));
    XB[i] = f2bf(TMP[row * 2048 + 1024 + c]);
}
__global__ void k_conv4_naive(const bf16_t* XB, const float* cw  , const float* cb, int dir, bf16_t* U) {
    const size_t i = (size_t)blockIdx.x * 256 + threadIdx.x;
    const int row = (int)(i / D), c = (int)(i % D);
    const int t = row_tok(row), L = row_len(row), base = row - t;
    float v = cb[c];
#pragma unroll
    for (int k = 0; k < 4; ++k) { const int tt = dir == 0 ? t + k - 3 : t + 3 - k; if (tt >= 0 && tt < L) v += cw[k * D + c] * bf2f(XB[(size_t)(base + tt) * D + c]); }
    U[i] = f2bf(v);
}
__global__ void k_scan_naive(const bf16_t* GT, const bf16_t* U, const float* lam  , int dir, bf16_t* HF, const bf16_t* G, bf16_t* Y) {
    const int idx = blockIdx.x * 256 + threadIdx.x, b = idx >> 10, c = idx & 1023;
    const float sp = log1pf(expf(-lam[c]));
    float h = 0.f;
    for (int s = 0; s < TKV; ++s) {
        int row;
        if (s < CTXL) row = ML + b * CTXL + (dir == 0 ? s : CTXL - 1 - s); else row = b * SEQ + (dir == 0 ? s - CTXL : SEQ - 1 - (s - CTXL));
        const size_t o = (size_t)row * D + c;
        const float r = 1.f / (1.f + expf(-bf2f(GT[o]))), ig = 1.f / (1.f + expf(-bf2f(GT[(size_t)M * D + o])));
        const float la = -8.f * r * sp, a = expf(la);
        float mult = sqrtf(-expm1f(2.f * la)); if (s == 0) mult = 1.f;
        h = a * h + mult * ig * bf2f(U[o]);
        if (dir == 0) HF[o] = f2bf(h); else Y[o] = f2bf((bf2f(HF[o]) + h) * bf2f(G[o]));
    }
}

#define LAS __attribute__((address_space(3)))
#define GAS __attribute__((address_space(1)))
typedef short bf16x8 __attribute__((ext_vector_type(8)));
typedef float f32x4 __attribute__((ext_vector_type(4)));
typedef float f32x2 __attribute__((ext_vector_type(2)));
typedef unsigned u32x4 __attribute__((ext_vector_type(4)));
typedef unsigned u32x2 __attribute__((ext_vector_type(2)));
#ifndef MK_AFFINE
#define MK_AFFINE 1
#endif
#ifndef MK_CHAIN
#define MK_CHAIN 1
#endif
constexpr int NWAVES = 8, NTHR = 512;
constexpr int RING_BYTES = 131072, LDSCTL_OFF = 139264, LDS_BYTES = 143360;

constexpr size_t WT_W1 = 0, WT_W2 = WT_W1 + (size_t)4 * D * DFF, WT_QKV = WT_W2 + (size_t)4 * D * DFF, WT_WO = WT_QKV + (size_t)2 * D * 1536,
                 WT_CIN = WT_WO + (size_t)2 * D * D, WT_COUT = WT_CIN + (size_t)D * 2048, WT_LIN = WT_COUT + (size_t)D * D, WT_LOUT = WT_LIN + (size_t)D * 2048, WT_END = WT_LOUT + (size_t)D * D;
static_assert(WT_END * 2 <= 88 * MiB, "weight copies fit their region");
constexpr int SW_MLP = 0, SW_QKV = SW_MLP + 4 * 9 * DFF, SW_CIN = SW_QKV + 2 * 9 * 1536, SW_LIN = SW_CIN + 9 * 2048, SW_END = SW_LIN + 9 * 2048;
static_assert(SW_END * 4 <= (int)MiB, "SW fits");
constexpr size_t OFF_MODP = OFF_BIG;
constexpr size_t OFF_ROPE = OFF_TAB, OFF_SP = OFF_TAB + 16384;

__device__ __forceinline__ unsigned cvt_pk_bf16(float lo, float hi) { f32x2 v = {lo, hi}; typedef __bf16 bf16x2_t __attribute__((ext_vector_type(2))); bf16x2_t b = __builtin_convertvector(v, bf16x2_t); return __builtin_bit_cast(unsigned, b); }
__device__ __forceinline__ float shx(float v, int mask, int lane) { return __builtin_bit_cast(float, __builtin_amdgcn_ds_bpermute((lane ^ mask) << 2, __builtin_bit_cast(int, v))); }
__device__ __forceinline__ float wave_sum(float v, int lane) {
#pragma unroll
    for (int o = 1; o < 64; o <<= 1) v += shx(v, o, lane);
    return v;
}
__device__ __forceinline__ float fast_sigmoid(float x) { return __builtin_amdgcn_rcpf(1.f + __builtin_amdgcn_exp2f(-1.4426950408889634f * x)); }

#define XB_TMO      128
#define XB_XCNT(j)  (256  + 64 * (j))
#define XB_XSUB(j)  (1280 + 64 * (j))
#define XB_XGEN(j)  (2304 + 64 * (j))
#define XB_TOP      3328
#define XB_TOPGEN   3392
#define XB_LSUB(j)  (3456 + 64 * (j))
#define XB_LGEN(j)  (4480 + 64 * (j))
#define XCD_BAR_WORDS 5504
#define XB_SPIN_CAP (1u << 18)
__device__ __forceinline__ unsigned xb_ld(unsigned* p)              { return __hip_atomic_load(p, __ATOMIC_RELAXED, __HIP_MEMORY_SCOPE_AGENT); }
__device__ __forceinline__ unsigned xb_add(unsigned* p, unsigned v) { return __hip_atomic_fetch_add(p, v, __ATOMIC_RELAXED, __HIP_MEMORY_SCOPE_AGENT); }
__device__ __forceinline__ unsigned xb_xcc_id() { return (unsigned)__builtin_amdgcn_s_getreg((3 << 11) | 20) & 0xFu; }
#define XB_SPIN(cond, bar) do { unsigned _sp = 0; while (cond) { __builtin_amdgcn_s_sleep(1); \
    if ((++_sp & 255u) == 0u) { if (xb_ld(&(bar)[XB_TMO])) break; if (_sp > XB_SPIN_CAP) { atomicAdd(&(bar)[XB_TMO], 1u); break; } } } } while (0)
struct XcdBarrier { unsigned* bar; unsigned x; volatile LAS unsigned* st; };
__device__ __forceinline__ XcdBarrier xcd_barrier_post(unsigned* bar, volatile LAS unsigned* st) {
    XcdBarrier b; b.bar = bar; b.x = xb_xcc_id(); b.st = st;
    if (threadIdx.x == 0) st[4] = xb_add(&bar[XB_XCNT(b.x)], 1u);
    return b;
}
__device__ __forceinline__ void xcd_barrier_complete(unsigned* bar, unsigned x, unsigned& nloc, unsigned& nx) {
    const unsigned G = gridDim.x * gridDim.y * gridDim.z;
    unsigned sum, cnt, mine, sp = 0u;
    for (;;) {
        sum = 0u; cnt = 0u; mine = 0u;
#pragma unroll
        for (unsigned j = 0; j < 16; ++j) { const unsigned c = xb_ld(&bar[XB_XCNT(j)]); sum += c; cnt += (c > 0u) ? 1u : 0u; mine = (j == x) ? c : mine; }
        if (sum == G) break;
        __builtin_amdgcn_s_sleep(1);
        if ((++sp & 255u) == 0u) { if (xb_ld(&bar[XB_TMO])) break; if (sp > XB_SPIN_CAP) { atomicAdd(&bar[XB_TMO], 1u); break; } }
    }
    nloc = mine > 0u ? mine : 1u; nx = cnt > 0u ? cnt : 1u;
}
__device__ __forceinline__ void xcd_barrier(const XcdBarrier& b, const int tid) {
    asm volatile("s_waitcnt vmcnt(0)" ::: "memory");
    __syncthreads();
    if (tid == 0) {
        unsigned* bar; { unsigned long long bp = (unsigned long long)b.bar; asm volatile("" : "+s"(bp)); bar = (unsigned*)(GAS unsigned*)bp; }
        __builtin_amdgcn_s_waitcnt(0);
        unsigned nloc = b.st[0], nx = b.st[1];
        if (nloc == 0u) { xcd_barrier_complete(bar, b.x, nloc, nx); b.st[0] = nloc; b.st[1] = nx; }
        const unsigned old = xb_add(&bar[XB_XSUB(b.x)], 1u);
        const unsigned gen = old / nloc;
        if (old + 1u == (gen + 1u) * nloc) {
            __builtin_amdgcn_fence(__ATOMIC_RELEASE, "agent");
            asm volatile("s_waitcnt vmcnt(0)" ::: "memory");
            const unsigned og = xb_add(&bar[XB_TOP], 1u);
            const unsigned tg = og / nx;
            if (og + 1u == (tg + 1u) * nx) xb_add(&bar[XB_TOPGEN], 1u);
            else XB_SPIN(xb_ld(&bar[XB_TOPGEN]) == tg, bar);
            __builtin_amdgcn_fence(__ATOMIC_ACQUIRE, "agent");
            xb_add(&bar[XB_XGEN(b.x)], 1u);
            asm volatile("s_waitcnt vmcnt(0)" ::: "memory");
        } else {
            XB_SPIN(xb_ld(&bar[XB_XGEN(b.x)]) == gen, bar);
            __builtin_amdgcn_fence(__ATOMIC_ACQUIRE, "agent");
            asm volatile("s_waitcnt vmcnt(0)" ::: "memory");
        }
    }
    __syncthreads();
}

__device__ __forceinline__ void xcd_local_barrier(const XcdBarrier& b, const int tid) {
    asm volatile("s_waitcnt vmcnt(0)" ::: "memory");
    __syncthreads();
    if (tid == 0) {
        unsigned* bar; { unsigned long long bp = (unsigned long long)b.bar; asm volatile("" : "+s"(bp)); bar = (unsigned*)(GAS unsigned*)bp; }
        __builtin_amdgcn_s_waitcnt(0);
        const unsigned nloc = b.st[0];
        const unsigned old = xb_add(&bar[XB_LSUB(b.x)], 1u);
        const unsigned gen = old / nloc;
        if (old + 1u == (gen + 1u) * nloc) xb_add(&bar[XB_LGEN(b.x)], 1u);
        else XB_SPIN(xb_ld(&bar[XB_LGEN(b.x)]) == gen, bar);
        asm volatile("s_waitcnt vmcnt(0)\n\tbuffer_inv sc0\n\ts_waitcnt vmcnt(0)" ::: "memory");
    }
    __syncthreads();
}

template <typename T> __device__ __forceinline__ T ldu(const void* ubase, unsigned voff) { return *(const T*)((const char*)ubase + voff); }
template <typename T> __device__ __forceinline__ void stu(void* ubase, unsigned voff, T v) { *(T*)((char*)ubase + voff) = v; }
template <typename T> __device__ __forceinline__ T ldu_nt(const void* ubase, unsigned voff) { return __builtin_nontemporal_load((const T*)((const char*)ubase + voff)); }
namespace pg8 {
constexpr int BM = 256, BK = 64, HALF = 128, HTB = HALF * BK * 2, NXCD = 8, WGM = 8;
__device__ __forceinline__ int lds_byte(int r, int c) { const int st = (r >> 4) * 2 + (c >> 5), rr = r & 15, cc = c & 31, ob = rr * 64 + cc * 2; return st * 1024 + (ob ^ (((ob >> 9) & 1) << 5)); }
__device__ __forceinline__ void stage_rc(int b, int& R, int& C) { const int st = b / 1024, sb = b % 1024, swz = sb ^ (((sb >> 9) & 1) << 5); R = (st >> 1) * 16 + swz / 64; C = (st & 1) * 32 + (swz % 64) / 2; }
__device__ __forceinline__ int perm32(int rho) { const int n = rho >> 4, i = rho & 15; return 8 * (i >> 2) + 4 * n + (i & 3); }
__device__ __forceinline__ int qkvmap(int R) { const int w = R >> 5, rho = R & 31, n = rho >> 4, i = rho & 15, fq = i >> 2, j = i & 3; return 64 * w + 32 * (fq >> 1) + 8 * (fq & 1) + 4 * n + j; }

struct Unit { int pm, pn; };
struct Sched {
    int nM0, nN0, pm00, pn00, nM1, nN1, pm01, pn01, G, c;
    int aff, xx, xr, xn, nctx;
    __device__ __forceinline__ bool next(int i, Unit& u) const {
        if (aff) { const int L = i * xn + xr, nl = 8 * nN0;
            if (L < nl) { u.pm = 8 * xx + L / nN0; u.pn = L % nN0; return true; }
            if (L < nl + nctx) { u.pm = 64 + xx; u.pn = (nctx == nN0 ? 0 : pn01) + (L - nl); return true; }
            return false; }
        int L = i * G + c; bool s = false;
        const int n0 = nM0 * nN0;
        if (L >= n0) { L -= n0; s = true; if (L >= nM1 * nN1) return false; }
        const int nm = s ? nM1 : nM0, nn = s ? nN1 : nN0, nwg = nm * nn;
        int wgid = L; { const int q = nwg / NXCD, r = nwg % NXCD, xcd = wgid % NXCD, off = wgid / NXCD; wgid = (xcd < r ? xcd * (q + 1) : r * (q + 1) + (xcd - r) * q) + off; }
        const int nig = WGM * nn, gid = wgid / nig, fm = gid * WGM, gsz = (nm - fm) < WGM ? (nm - fm) : WGM;
        u.pm = (s ? pm01 : pm00) + fm + ((wgid % nig) % gsz); u.pn = (s ? pn01 : pn00) + (wgid % nig) / gsz; return true;
    }
};
struct Gemm { const bf16_t* A; const bf16_t* Bt; int K; long tstepB, hstepB; int bmap; };

enum { EK_MLP1 = 1, EK_RES = 2, EK_GLU = 3, EK_LRUIN = 4, EK_QKV = 5 };
struct Epi {
    int kind;
    const float* ssq;
    const float* sw;
    int N;
    bf16_t* o0; bf16_t* o1; bf16_t* o2;
    float* xl; float* xc;
    const float* xrl; const float* xrc;
    const float* gate;
    const float* bias;
    const float* gain;
    bf16_t* xg; float* ssq_out;
    const float* qg; const float* kg; const float* rope;
};

__device__ __forceinline__ void st_tile64(LAS unsigned char* sc, int lane, int fr, int fq, const u32x4& w, void* ubase, unsigned pitch) {
    *(LAS u32x4*)(sc + fr * 64 + ((fq ^ ((fr >> 1) & 3)) * 16)) = w;
    const u32x4 t = *(const LAS u32x4*)(sc + (lane >> 2) * 64 + (((lane & 3) ^ ((lane >> 3) & 3)) * 16));
    stu<u32x4>(ubase, (unsigned)(lane >> 2) * pitch + (unsigned)(lane & 3) * 16u, t);
}
template <int KIND>
__device__ __forceinline__ void epilogue(LAS unsigned char* lds, const Epi& E, f32x4 (&acc)[2][2][4][2], const Unit& u, int wr, int wc, int fr, int fq) {
    const int bi = u.pm < 64 ? (u.pm >> 3) : 8;
    const int rbase = u.pm * BM + wr * 64 + fr, lane = (fq << 4) | fr;
    LAS unsigned char* const scA = lds + 3 * HTB + (wr * 4 + wc) * 1024; LAS unsigned char* const scB = scA + 8192;
    const int rowu = u.pm * BM + wr * 64;
    float rsall[2][4];
    if constexpr (KIND != EK_RES) {
        f32x4 pp[2][4];
#pragma unroll
        for (int ai = 0; ai < 2; ++ai)
#pragma unroll
            for (int m = 0; m < 4; ++m) pp[ai][m] = __builtin_nontemporal_load((const f32x4*)(E.ssq + (size_t)(rbase + ai * HALF + m * 16) * 16 + 4 * fq));
#pragma unroll
        for (int ai = 0; ai < 2; ++ai)
#pragma unroll
            for (int m = 0; m < 4; ++m) { float sq = (pp[ai][m][0] + pp[ai][m][1]) + (pp[ai][m][2] + pp[ai][m][3]); sq += shx(sq, 16, lane); sq += shx(sq, 32, lane); rsall[ai][m] = rsqrtf(sq * (1.f / D) + EPS); }
    }
    if constexpr (KIND == EK_MLP1) {
        const int c0 = u.pn * BM + wc * 32 + 8 * fq;
        f32x4 sw[2][2];
#pragma unroll
        for (int bj = 0; bj < 2; ++bj)
#pragma unroll
            for (int n = 0; n < 2; ++n) sw[bj][n] = *(const f32x4*)(E.sw + (size_t)bi * E.N + c0 + bj * HALF + 4 * n);
#pragma unroll
        for (int ai = 0; ai < 2; ++ai)
#pragma unroll
            for (int m = 0; m < 4; ++m) { const int r = rbase + ai * HALF + m * 16; const float rs = rsall[ai][m];
                bf16_t* rowu_p = E.o0 + (size_t)(rowu + ai * HALF + m * 16) * DFF + u.pn * BM + wc * 32; (void)r;
#pragma unroll
                for (int bj = 0; bj < 2; ++bj) { f32x4 v0 = acc[ai][bj][m][0] * rs + sw[bj][0], v1 = acc[ai][bj][m][1] * rs + sw[bj][1];
#pragma unroll
                    for (int j = 0; j < 4; ++j) { const float a = fmaxf(v0[j], 0.f), b = fmaxf(v1[j], 0.f); v0[j] = a * a; v1[j] = b * b; }
                    u32x4 w; w.x = cvt_pk_bf16(v0[0], v0[1]); w.y = cvt_pk_bf16(v0[2], v0[3]); w.z = cvt_pk_bf16(v1[0], v1[1]); w.w = cvt_pk_bf16(v1[2], v1[3]);
                    st_tile64(bj ? scB : scA, lane, fr, fq, w, rowu_p + bj * HALF, DFF * 2u); } }
    } else if constexpr (KIND == EK_RES) {
        const int trow = u.pm * BM + wr * 64 - (u.pm < 64 ? 0 : ML);
        const int cw = u.pn * BM + wc * 32;
        const float* xr_u = (u.pm < 64 ? E.xrl : E.xrc) + (size_t)trow * D + cw;
        float* xw_u = (u.pm < 64 ? E.xl : E.xc) + (size_t)trow * D + cw;
        bf16_t* xg_u = E.xg + (size_t)(u.pm * BM + wr * 64) * D + cw;
        const unsigned vo4 = (unsigned)(fr * D + 8 * fq) * 4u;
        const int wid_ = wr * 4 + wc;
        LAS unsigned char* sx_w = lds + 3 * HTB + wid_ * 1024 + (fr >> 3) * 8192 + (fr & 7) * 128;
        const int pw0 = ((2 * fq) ^ (fr & 7)) * 16, pw1 = ((2 * fq + 1) ^ (fr & 7)) * 16;
        const LAS unsigned char* sx_r = lds + 3 * HTB + wid_ * 1024 + (lane >> 3) * 128 + (((lane & 7) ^ (lane >> 3)) * 16);
        const unsigned vsx = (unsigned)((lane >> 3) * D + (lane & 7) * 4) * 4u;
        LAS unsigned char* sg_w = lds + RING_BYTES + wid_ * 1024 + fr * 64 + ((fq ^ ((fr >> 1) & 3)) * 16);
        const LAS unsigned char* sg_r = lds + RING_BYTES + wid_ * 1024 + (lane >> 2) * 64 + (((lane & 3) ^ ((lane >> 3) & 3)) * 16);
        const unsigned vsg = (unsigned)((lane >> 2) * D + (lane & 3) * 8) * 2u;
        float qs[8];
#pragma unroll
        for (int g8 = 0; g8 < 8; ++g8) qs[g8] = 0.f;
#pragma unroll
        for (int bj = 0; bj < 2; ++bj) {
            const int c = cw + bj * HALF + 8 * fq;
            const f32x4 gt0 = *(const f32x4*)(E.gate + (size_t)bi * 6144 + c), gt1 = *(const f32x4*)(E.gate + (size_t)bi * 6144 + c + 4);
            const f32x4 bs0 = E.bias ? *(const f32x4*)(E.bias + c) : (f32x4){0.f, 0.f, 0.f, 0.f}, bs1 = E.bias ? *(const f32x4*)(E.bias + c + 4) : (f32x4){0.f, 0.f, 0.f, 0.f};
            const f32x4 gn0 = E.gain ? *(const f32x4*)(E.gain + (size_t)bi * D + c) : (f32x4){0.f, 0.f, 0.f, 0.f}, gn1 = E.gain ? *(const f32x4*)(E.gain + (size_t)bi * D + c + 4) : (f32x4){0.f, 0.f, 0.f, 0.f};
#define RES_ROW(g8_) (((g8_) >> 2) * HALF + ((g8_) & 3) * 16)
            f32x4 xr[4][2];
#pragma unroll
            for (int g8 = 0; g8 < 4; ++g8) { const float* q_ = xr_u + (size_t)RES_ROW(g8) * D + bj * HALF; xr[g8][0] = ldu_nt<f32x4>(q_, vo4); xr[g8][1] = ldu_nt<f32x4>(q_ + 4, vo4); }
#pragma unroll
            for (int g8 = 0; g8 < 8; ++g8) { const int ai = g8 >> 2, m = g8 & 3;
                const f32x4 xc0 = xr[g8 & 3][0], xc1 = xr[g8 & 3][1];
                if (g8 < 4) { const float* q_ = xr_u + (size_t)RES_ROW(g8 + 4) * D + bj * HALF; xr[g8 & 3][0] = ldu_nt<f32x4>(q_, vo4); xr[g8 & 3][1] = ldu_nt<f32x4>(q_ + 4, vo4); }
                const f32x4 x0 = xc0 + gt0 * (acc[ai][bj][m][0] + bs0), x1 = xc1 + gt1 * (acc[ai][bj][m][1] + bs1);
                float* w_ = xw_u + (size_t)RES_ROW(g8) * D + bj * HALF;
                *(LAS f32x4*)(sx_w + pw0) = x0; *(LAS f32x4*)(sx_w + pw1) = x1;
                { const f32x4 t0 = *(const LAS f32x4*)sx_r, t1 = *(const LAS f32x4*)(sx_r + 8192); stu<f32x4>(w_, vsx, t0); stu<f32x4>(w_ + 8 * D, vsx, t1); }
                if (E.gain) {
                    qs[g8] += (x0[0] * x0[0] + x0[1] * x0[1]) + (x0[2] * x0[2] + x0[3] * x0[3]) + (x1[0] * x1[0] + x1[1] * x1[1]) + (x1[2] * x1[2] + x1[3] * x1[3]);
                    const f32x4 y0 = x0 * gn0, y1 = x1 * gn1;
                    u32x4 w; w.x = cvt_pk_bf16(y0[0], y0[1]); w.y = cvt_pk_bf16(y0[2], y0[3]); w.z = cvt_pk_bf16(y1[0], y1[1]); w.w = cvt_pk_bf16(y1[2], y1[3]);
                    *(LAS u32x4*)sg_w = w;
                    { const u32x4 tw = *(const LAS u32x4*)sg_r; stu<u32x4>(xg_u + (size_t)RES_ROW(g8) * D + bj * HALF, vsg, tw); } } }
        }
        if (E.gain) {
            float* sq_u = E.ssq_out + (size_t)(u.pm * BM + wr * 64) * 16 + 4 * u.pn + wc;
#pragma unroll
            for (int g8 = 0; g8 < 8; ++g8) { float q = qs[g8]; q += shx(q, 16, lane); q += shx(q, 32, lane);
                if (fq == 0) stu<float>(sq_u + (size_t)RES_ROW(g8) * 16, (unsigned)fr * 64u, q); }
        }
#undef RES_ROW
    } else if constexpr (KIND == EK_GLU) {
        const int c0 = u.pn * HALF + wc * 32 + 8 * fq;
        f32x4 sw[2][2];
#pragma unroll
        for (int bj = 0; bj < 2; ++bj)
#pragma unroll
            for (int n = 0; n < 2; ++n) sw[bj][n] = *(const f32x4*)(E.sw + (size_t)bi * E.N + bj * D + c0 + 4 * n);
#pragma unroll
        for (int ai = 0; ai < 2; ++ai)
#pragma unroll
            for (int m = 0; m < 4; ++m) { const int r = rbase + ai * HALF + m * 16; const float rs = rsall[ai][m];
                f32x4 a0 = acc[ai][0][m][0] * rs + sw[0][0], a1 = acc[ai][0][m][1] * rs + sw[0][1], g0 = acc[ai][1][m][0] * rs + sw[1][0], g1 = acc[ai][1][m][1] * rs + sw[1][1];
#pragma unroll
                for (int j = 0; j < 4; ++j) { a0[j] *= fast_sigmoid(g0[j]); a1[j] *= fast_sigmoid(g1[j]); }
                u32x4 w; w.x = cvt_pk_bf16(a0[0], a0[1]); w.y = cvt_pk_bf16(a0[2], a0[3]); w.z = cvt_pk_bf16(a1[0], a1[1]); w.w = cvt_pk_bf16(a1[2], a1[3]);
                *(u32x4*)(E.o0 + (size_t)r * D + c0) = w; }
    } else if constexpr (KIND == EK_LRUIN) {
        const int c0 = u.pn * BM + wc * 32 + 8 * fq;
        f32x4 sw[2][2];
#pragma unroll
        for (int bj = 0; bj < 2; ++bj)
#pragma unroll
            for (int n = 0; n < 2; ++n) sw[bj][n] = *(const f32x4*)(E.sw + (size_t)bi * E.N + c0 + bj * HALF + 4 * n);
        const bool isg = u.pn < 4;
        bf16_t* ob = isg ? E.o0 + c0 : E.o1 + (c0 - D);
#pragma unroll
        for (int ai = 0; ai < 2; ++ai)
#pragma unroll
            for (int m = 0; m < 4; ++m) { const int r = rbase + ai * HALF + m * 16; const float rs = rsall[ai][m];
#pragma unroll
                for (int bj = 0; bj < 2; ++bj) { f32x4 v0 = acc[ai][bj][m][0] * rs + sw[bj][0], v1 = acc[ai][bj][m][1] * rs + sw[bj][1];
                    if (isg) {
#pragma unroll
                        for (int j = 0; j < 4; ++j) { const float x = v0[j], y = v1[j];
                            v0[j] = x * fast_sigmoid(1.5957691216057308f * (x + 0.044715f * x * x * x)); v1[j] = y * fast_sigmoid(1.5957691216057308f * (y + 0.044715f * y * y * y)); } }
                    u32x4 w; w.x = cvt_pk_bf16(v0[0], v0[1]); w.y = cvt_pk_bf16(v0[2], v0[3]); w.z = cvt_pk_bf16(v1[0], v1[1]); w.w = cvt_pk_bf16(v1[2], v1[3]);
                    *(u32x4*)(ob + (size_t)r * D + bj * HALF) = w; } }
    } else {
        const int a = fq >> 1, f0 = 8 * (fq & 1), d0 = 32 * a + f0;
        const int colh = u.pn * BM + wc * 64;
        f32x4 sw[2][2], gg[2][2];
        const float* gsrc = u.pn < 4 ? E.qg : E.kg;
#pragma unroll
        for (int bj = 0; bj < 2; ++bj)
#pragma unroll
            for (int n = 0; n < 2; ++n) { sw[bj][n] = *(const f32x4*)(E.sw + (size_t)bi * E.N + colh + d0 + 16 * bj + 4 * n); gg[bj][n] = *(const f32x4*)(gsrc + d0 + 16 * bj + 4 * n); }
        const bool lat = u.pm < 64;
        const float osc = u.pn < 4 ? QSCALE : 1.f;
#pragma unroll
        for (int ai = 0; ai < 2; ++ai)
#pragma unroll
            for (int m = 0; m < 4; ++m) { const int r = rbase + ai * HALF + m * 16; const float rs = rsall[ai][m];
                f32x4 x1[2], x2[2];
#pragma unroll
                for (int n = 0; n < 2; ++n) { x1[n] = acc[ai][0][m][n] * rs + sw[0][n]; x2[n] = acc[ai][1][m][n] * rs + sw[1][n]; }
                if (u.pn < 5) {
                    float q = 0.f;
#pragma unroll
                    for (int n = 0; n < 2; ++n)
#pragma unroll
                        for (int j = 0; j < 4; ++j) q += x1[n][j] * x1[n][j] + x2[n][j] * x2[n][j];
                    q += shx(q, 16, lane); q += shx(q, 32, lane);
                    const float hr = rsqrtf(q * (1.f / 64.f) + EPS) * osc;
#pragma unroll
                    for (int n = 0; n < 2; ++n) { x1[n] = x1[n] * gg[0][n] * hr; x2[n] = x2[n] * gg[1][n] * hr; }
                    if (lat) {
                        const int t = r & 2047, pos = a == 0 ? (t >> 6) : (t & 63);
#pragma unroll
                        for (int n = 0; n < 2; ++n) { const f32x4 cs = *(const f32x4*)(E.rope + pos * 16 + f0 + 4 * n), sn = *(const f32x4*)(E.rope + 1024 + pos * 16 + f0 + 4 * n);
                            const f32x4 y1 = x1[n] * cs - x2[n] * sn, y2 = x1[n] * sn + x2[n] * cs; x1[n] = y1; x2[n] = y2; }
                    }
                }
                u32x4 w1, w2; w1.x = cvt_pk_bf16(x1[0][0], x1[0][1]); w1.y = cvt_pk_bf16(x1[0][2], x1[0][3]); w1.z = cvt_pk_bf16(x1[1][0], x1[1][1]); w1.w = cvt_pk_bf16(x1[1][2], x1[1][3]);
                w2.x = cvt_pk_bf16(x2[0][0], x2[0][1]); w2.y = cvt_pk_bf16(x2[0][2], x2[0][3]); w2.z = cvt_pk_bf16(x2[1][0], x2[1][1]); w2.w = cvt_pk_bf16(x2[1][2], x2[1][3]);
                bf16_t* op;
                if (u.pn < 4) op = E.o0 + (size_t)r * D + colh + d0;
                else { const int kvr = lat ? (r >> 11) * TKV + CTXL + (r & 2047) : ((r - ML) >> 8) * TKV + ((r - ML) & 255); op = (u.pn == 4 ? E.o1 : E.o2) + (size_t)kvr * 256 + wc * 64 + d0; }
                *(u32x4*)op = w1; *(u32x4*)(op + 16) = w2; }
    }
}

template <int KIND>
__device__ __forceinline__ void gemm_phase(LAS unsigned char* lds, const int tid, const Gemm g, const Sched S, const Epi E) {
    const int wid = __builtin_amdgcn_readfirstlane(tid >> 6), lane = tid & 63, wr = wid >> 2, wc = wid & 3, fr = lane & 15, fq = lane >> 4;
    const int K = g.K, nt = K / BK;
    unsigned voffA[2], voffB[2];
#pragma unroll
    for (int i = 0; i < 2; ++i) { int R, C; stage_rc(tid * 16 + i * 8192, R, C); const int Rb = g.bmap == 0 ? ((R & ~31) + perm32(R & 31)) : qkvmap(R);
        voffA[i] = (unsigned)(R * K + C) * 2u; voffB[i] = (unsigned)(Rb * K + C) * 2u; }
    const size_t kstep = (size_t)(BK * 2);
    const size_t hstepA = (size_t)HALF * K * 2, tstepA = 2 * hstepA;
    const size_t hstepB = (size_t)g.hstepB, tstepB = (size_t)g.tstepB;
    const unsigned ldsw = (unsigned)wid * 1024u;
    const int aoff = lds_byte(wr * 64 + fr, fq * 8), boff = lds_byte(wc * 32 + fr, fq * 8);
#define PG8_SA(b, h) (((b) * 2 + (h)) * HTB)
#define PG8_SB(b, h) ((4 + (b) * 2 + (h)) * HTB)
#define PG8_STAGE(bufoff, gbase, voff) do { _Pragma("unroll") for (int _i = 0; _i < 2; ++_i) \
        __builtin_amdgcn_global_load_lds((const unsigned*)((const char*)(gbase) + (voff)[_i]), (LAS unsigned*)(lds + (bufoff) + ldsw + _i * 8192), 16, 0, 0); } while (0)
#define PG8_LDA(dst, b, h) do { _Pragma("unroll") for (int m = 0; m < 4; ++m) _Pragma("unroll") for (int k = 0; k < 2; ++k) dst[m][k] = *(const LAS bf16x8*)(lds + PG8_SA(b, h) + aoff + m * 2048 + k * 1024); } while (0)
#define PG8_LDB(dst, b, h) do { _Pragma("unroll") for (int n = 0; n < 2; ++n) _Pragma("unroll") for (int k = 0; k < 2; ++k) dst[n][k] = *(const LAS bf16x8*)(lds + PG8_SB(b, h) + boff + n * 2048 + k * 1024); } while (0)
#define PG8_MMA(ai, bj, At, Bt) do { __builtin_amdgcn_s_setprio(1); _Pragma("unroll") for (int m = 0; m < 4; ++m) _Pragma("unroll") for (int n = 0; n < 2; ++n) _Pragma("unroll") for (int k = 0; k < 2; ++k) \
        acc[ai][bj][m][n] = __builtin_amdgcn_mfma_f32_16x16x32_bf16(Bt[n][k], At[m][k], acc[ai][bj][m][n], 0, 0, 0); __builtin_amdgcn_s_setprio(0); } while (0)
#define PG8_WAIT_V(n) asm volatile("s_waitcnt vmcnt(" #n ")" ::: "memory")
#define PG8_WAIT_L(n) asm volatile("s_waitcnt lgkmcnt(" #n ")" ::: "memory")
#define PG8_BAR __builtin_amdgcn_s_barrier()
#define PG8_SCHED __builtin_amdgcn_sched_barrier(0)
    Unit cur, nxt; int ui = 0;
    if (!S.next(0, cur)) return;
    f32x4 acc[2][2][4][2];
#pragma unroll
    for (int a = 0; a < 2; ++a)
#pragma unroll
        for (int b = 0; b < 2; ++b)
#pragma unroll
            for (int m = 0; m < 4; ++m)
#pragma unroll
                for (int n = 0; n < 2; ++n) acc[a][b][m][n] = (f32x4){0.f, 0.f, 0.f, 0.f};
    bf16x8 At[4][2], B0[2][2], B1[2][2];
    const char* cA = (const char*)g.A + (size_t)cur.pm * tstepA; const char* cB = (const char*)g.Bt + (size_t)cur.pn * tstepB;
    PG8_STAGE(PG8_SB(0, 0), cB, voffB); PG8_STAGE(PG8_SB(0, 1), cB + hstepB, voffB); PG8_STAGE(PG8_SA(0, 0), cA, voffA); PG8_STAGE(PG8_SA(0, 1), cA + hstepA, voffA);
    if (wr == 1) PG8_BAR;
    PG8_WAIT_V(2); PG8_BAR;
    PG8_STAGE(PG8_SB(1, 0), cB + kstep, voffB); PG8_STAGE(PG8_SA(1, 0), cA + kstep, voffA); PG8_STAGE(PG8_SB(1, 1), cB + hstepB + kstep, voffB);
    PG8_WAIT_V(6); PG8_BAR;
    for (;;) {
        const bool has_next = S.next(ui + 1, nxt);
        const char* nA = has_next ? (const char*)g.A + (size_t)nxt.pm * tstepA : cA; const char* nB = has_next ? (const char*)g.Bt + (size_t)nxt.pn * tstepB : cB;
        for (int t = 0; t < nt; t += 2) {
            const bool last = (t == nt - 2);
            const char* a1 = cA + (size_t)(t + 1) * kstep;
            const char* a2 = last ? nA : cA + (size_t)(t + 2) * kstep; const char* b2 = last ? nB : cB + (size_t)(t + 2) * kstep;
            const char* a3 = a2 + kstep; const char* b3 = b2 + kstep;
            PG8_LDB(B0, 0, 0); PG8_LDB(B1, 0, 1); PG8_SCHED; PG8_LDA(At, 0, 0); PG8_STAGE(PG8_SA(1, 1), a1 + hstepA, voffA);
            PG8_WAIT_V(8); PG8_WAIT_L(0); PG8_BAR; PG8_MMA(0, 0, At, B0); PG8_MMA(0, 1, At, B1); PG8_BAR; PG8_SCHED;
            PG8_LDA(At, 0, 1); PG8_STAGE(PG8_SB(0, 0), b2, voffB); PG8_STAGE(PG8_SB(0, 1), b2 + hstepB, voffB); PG8_STAGE(PG8_SA(0, 0), a2, voffA);
            PG8_WAIT_V(8); PG8_WAIT_L(0); PG8_BAR; PG8_MMA(1, 0, At, B0); PG8_MMA(1, 1, At, B1); PG8_BAR; PG8_SCHED;
            PG8_LDB(B0, 1, 0); PG8_LDB(B1, 1, 1); PG8_SCHED; PG8_LDA(At, 1, 0); PG8_STAGE(PG8_SA(0, 1), a2 + hstepA, voffA);
            PG8_WAIT_V(8); PG8_WAIT_L(0); PG8_BAR; PG8_MMA(0, 0, At, B0); PG8_MMA(0, 1, At, B1); PG8_BAR; PG8_SCHED;
            PG8_LDA(At, 1, 1); PG8_STAGE(PG8_SB(1, 0), b3, voffB); PG8_STAGE(PG8_SB(1, 1), b3 + hstepB, voffB); PG8_STAGE(PG8_SA(1, 0), a3, voffA);
            PG8_WAIT_V(8); PG8_WAIT_L(0); PG8_BAR; PG8_MMA(1, 0, At, B0); PG8_MMA(1, 1, At, B1); PG8_BAR; PG8_SCHED;
        }
        if (wr == 0) PG8_BAR;
        epilogue<KIND>(lds, E, acc, cur, wr, wc, fr, fq);
        if (!has_next) break;
#pragma unroll
        for (int a = 0; a < 2; ++a)
#pragma unroll
            for (int b = 0; b < 2; ++b)
#pragma unroll
                for (int m = 0; m < 4; ++m)
#pragma unroll
                    for (int n = 0; n < 2; ++n) acc[a][b][m][n] = (f32x4){0.f, 0.f, 0.f, 0.f};
        cur = nxt; cA = nA; cB = nB; ++ui;
        if (wr == 1) PG8_BAR;
    }
    PG8_WAIT_V(0);
    PG8_BAR;
#undef PG8_SA
#undef PG8_SB
#undef PG8_STAGE
#undef PG8_LDA
#undef PG8_LDB
#undef PG8_MMA
#undef PG8_WAIT_V
#undef PG8_WAIT_L
#undef PG8_BAR
#undef PG8_SCHED
}
}


namespace attn_body {
using bf16=unsigned short;
using bf16x8=__attribute__((ext_vector_type(8)))short;
using s16x4=__attribute__((ext_vector_type(4)))short;
using f32x16=__attribute__((ext_vector_type(16)))float;
using u32x4=__attribute__((ext_vector_type(4)))unsigned;
constexpr int D=64,QP=1024,KP=256;
constexpr int NW=8,QBLK=32,QB=QBLK*NW,KVBLK=64;
__device__ __forceinline__ int crow(int r,int hi){return (r&3)+8*(r>>2)+4*hi;}
#define SBAR() __builtin_amdgcn_sched_barrier(0)
constexpr int NSLOT=3, SLOTB=8192;
constexpr int LDS_K=0, LDS_V=NSLOT*SLOTB, LDS_WS=2*NSLOT*SLOTB, LDS_OST=LDS_WS+NW*64*4, LDS_BYTES=LDS_OST+NW*4096;
constexpr float C2=0.125f*1.4426950408889634f;
__device__ __forceinline__ void glds16(const void*gsrc,unsigned lds_dst){unsigned keep;
  asm volatile("s_mov_b32 %0, m0\n\ts_mov_b32 m0, %2\n\ts_nop 0\n\tglobal_load_lds_dwordx4 %1, off\n\ts_mov_b32 m0, %0":"=&s"(keep):"v"(gsrc),"s"(lds_dst):"memory");}
__device__ __forceinline__ float max3f(float a,float b,float c){float r;asm("v_max3_f32 %0, %1, %2, %3":"=v"(r):"v"(a),"v"(b),"v"(c));return r;}
__device__ __forceinline__ float max2f(float a,float b){float r;asm("v_max_f32_e32 %0, %1, %2":"=v"(r):"v"(a),"v"(b));return r;}
__device__ __forceinline__ float fadd_s(float a,float b){float r;asm("v_add_f32_e32 %0, %1, %2":"=v"(r):"v"(a),"v"(b));return r;}
__device__ __forceinline__ float fsub_s(float a,float b){float r;asm("v_sub_f32_e32 %0, %1, %2":"=v"(r):"v"(a),"v"(b));return r;}
typedef float f32x2_t __attribute__((ext_vector_type(2))); typedef __bf16 bf16x2_t __attribute__((ext_vector_type(2)));
__device__ __forceinline__ unsigned cvtpk_s(float lo,float hi){f32x2_t v={lo,hi};bf16x2_t b=__builtin_convertvector(v,bf16x2_t);return __builtin_bit_cast(unsigned,b);}
#define WAIT_BAR(N) asm volatile("s_waitcnt vmcnt(" #N ") lgkmcnt(0)\n\ts_barrier":::"memory")

__device__ __forceinline__ void qkt(f32x16&p0,f32x16&p1,const char*Kslot,const bf16x8*qr,const f32x16&negm,int r32,int hi){
  const char*kb=Kslot+hi*1024+r32*16;
  #pragma unroll
  for(int d0=0;d0<4;++d0){
    const bf16x8 b0=*reinterpret_cast<const bf16x8*>(kb+d0*2048);
    const bf16x8 b1=*reinterpret_cast<const bf16x8*>(kb+d0*2048+512);
    if(d0==0){p0=__builtin_amdgcn_mfma_f32_32x32x16_bf16(b0,qr[0],negm,0,0,0);p1=__builtin_amdgcn_mfma_f32_32x32x16_bf16(b1,qr[0],negm,0,0,0);}
    else{p0=__builtin_amdgcn_mfma_f32_32x32x16_bf16(b0,qr[d0],p0,0,0,0);p1=__builtin_amdgcn_mfma_f32_32x32x16_bf16(b1,qr[d0],p1,0,0,0);}}
}
typedef __attribute__((address_space(3))) const char* lds_cptr;
typedef short v4i16_t __attribute__((ext_vector_type(4)));
__device__ __forceinline__ void kload8(bf16x8*kf,lds_cptr kp){
  kf[0]=*(const __attribute__((address_space(3))) bf16x8*)(kp);      kf[1]=*(const __attribute__((address_space(3))) bf16x8*)(kp+512);
  kf[2]=*(const __attribute__((address_space(3))) bf16x8*)(kp+2048); kf[3]=*(const __attribute__((address_space(3))) bf16x8*)(kp+2560);
  kf[4]=*(const __attribute__((address_space(3))) bf16x8*)(kp+4096); kf[5]=*(const __attribute__((address_space(3))) bf16x8*)(kp+4608);
  kf[6]=*(const __attribute__((address_space(3))) bf16x8*)(kp+6144); kf[7]=*(const __attribute__((address_space(3))) bf16x8*)(kp+6656);
}
__device__ __forceinline__ void kload2(bf16x8*kf,lds_cptr kp,int j){ kf[2*j]=*(const __attribute__((address_space(3))) bf16x8*)(kp+j*2048); kf[2*j+1]=*(const __attribute__((address_space(3))) bf16x8*)(kp+j*2048+512); }
__device__ __forceinline__ s16x4 vtr(lds_cptr p){ return __builtin_bit_cast(s16x4,__builtin_amdgcn_ds_read_tr16_b64_v4i16((__attribute__((address_space(3))) v4i16_t*)p)); }
__device__ __forceinline__ float rowmax(const f32x16&p0,const f32x16&p1){
  float a=max3f(p0[0],p0[1],p1[0]),b=max3f(p0[2],p0[3],p1[1]);a=max3f(a,p1[2],p1[3]);
  #pragma unroll
  for(int r=4;r<16;r+=4){a=max3f(a,p0[r],p0[r+1]);b=max3f(b,p0[r+2],p0[r+3]);a=max3f(a,p1[r],p1[r+1]);b=max3f(b,p1[r+2],p1[r+3]);}
  const float m=max2f(a,b);
  auto rr=__builtin_amdgcn_permlane32_swap(__float_as_uint(m),__float_as_uint(m),false,false);
  return max2f(__uint_as_float(rr[0]),__uint_as_float(rr[1]));
}
__device__ __forceinline__ void pv(f32x16*o,int vb,bf16x8 pa0,bf16x8 pa1,bf16x8 pa2,bf16x8 pa3){
  #pragma unroll
  for(int d0=0;d0<2;++d0){s16x4 lo[4],hi[4];
    #pragma unroll
    for(int ks=0;ks<4;++ks){
      asm volatile("ds_read_b64_tr_b16 %0,%1 offset:%c2":"=&v"(lo[ks]):"v"(vb),"i"(d0*4096+ks*1024):"memory");
      asm volatile("ds_read_b64_tr_b16 %0,%1 offset:%c2":"=&v"(hi[ks]):"v"(vb),"i"(d0*4096+ks*1024+512):"memory");}
    asm volatile("s_waitcnt lgkmcnt(0)":::"memory");SBAR();
    #define PK(k) (bf16x8){lo[k][0],lo[k][1],lo[k][2],lo[k][3],hi[k][0],hi[k][1],hi[k][2],hi[k][3]}
    o[d0]=__builtin_amdgcn_mfma_f32_32x32x16_bf16(pa0,PK(0),o[d0],0,0,0);
    o[d0]=__builtin_amdgcn_mfma_f32_32x32x16_bf16(pa1,PK(1),o[d0],0,0,0);
    o[d0]=__builtin_amdgcn_mfma_f32_32x32x16_bf16(pa2,PK(2),o[d0],0,0,0);
    o[d0]=__builtin_amdgcn_mfma_f32_32x32x16_bf16(pa3,PK(3),o[d0],0,0,0);
    #undef PK
  }
}

#ifndef ATTN_STORE16
#define ATTN_STORE16(p,v) (*(u32x4*)(p)=(v))
#endif
template<int THRL,bool NOMAX> __device__ __forceinline__ void attn_unit(const int tid,long qrow0,int h,long kvrow0,const int NT,const bf16*Q,const bf16*__restrict__ K,const bf16*__restrict__ V,bf16*O,char*shm){
  const int lane=tid&63,r32=lane&31,hi=lane>>5; const int wid=__builtin_amdgcn_readfirstlane(tid>>6);
  const bf16*Qw=Q+(qrow0+wid*QBLK)*QP+h*D;
  const bf16*Kh=K+kvrow0*KP+(h>>2)*D,*Vh=V+kvrow0*KP+(h>>2)*D;
  const unsigned lds0=(unsigned)(uintptr_t)shm;
  float*wsf=(float*)(shm+LDS_WS)+wid*64;
  const bf16*ksrc=Kh+(long)lane*KP+wid*8;
  const bf16*vsrc=Vh+(long)(16*(wid&3)+(lane>>2))*KP+(wid>>2)*32+(lane&3)*8;
  const unsigned kdst=lds0+LDS_K+wid*1024, vdst=lds0+LDS_V+wid*1024;
  #define DMA_K(t,slot) glds16(ksrc+(long)(t)*KVBLK*KP,(unsigned)__builtin_amdgcn_readfirstlane(kdst+(slot)))
  #define DMA_V(t,slot) glds16(vsrc+(long)(t)*KVBLK*KP,(unsigned)__builtin_amdgcn_readfirstlane(vdst+(slot)))
  const int vb0=(int)(lds0+LDS_V)+((lane>>4)&1)*32+(lane&3)*8+(4*hi+((lane&15)>>2))*64;
  const char*Kbase=shm+LDS_K; bf16x8 kf[8];
  const lds_cptr shm3=(lds_cptr)shm; const lds_cptr kp0=shm3+LDS_K+hi*1024+r32*16; const lds_cptr vp0=shm3+LDS_V+((lane>>4)&1)*32+(lane&3)*8+(4*hi+((lane&15)>>2))*64;
  DMA_K(0,0);DMA_V(0,0);DMA_K(1,SLOTB);
  bf16x8 qr[4];
  #pragma unroll
  for(int d0=0;d0<4;++d0)qr[d0]=*reinterpret_cast<const bf16x8*>(&Qw[(long)r32*QP+d0*16+hi*8]);
  float mhat=0.f,l_reg=0.f;f32x16 o[2];o[0]=f32x16{};o[1]=f32x16{};const f32x16 negm=f32x16{};
  #define CMASK(P0,P1,t) do{}while(0)
  bool resc=false;
  #define START(P0,P1) do{ if constexpr(!NOMAX){ const float rm=rowmax(P0,P1); resc=false; \
    { const float dl=rm; mhat=fadd_s(mhat,dl); \
      _Pragma("unroll") for(int r=0;r<16;++r){P0[r]=fsub_s(P0[r],dl);P1[r]=fsub_s(P1[r],dl);} \
      } } \
    _Pragma("unroll") for(int r=0;r<16;++r)P0[r]=__builtin_amdgcn_exp2f(P0[r]); }while(0)
  #define RESC() do{ if constexpr(!NOMAX){ if(resc){ asm volatile("s_waitcnt lgkmcnt(0)":::"memory"); \
      _Pragma("unroll") for(int d_=0;d_<2;++d_) _Pragma("unroll") for(int r=0;r<16;++r)o[d_][r]*=wsf[crow(r,hi)]; } } }while(0)
  f32x16 pA0,pA1,pB0,pB1;
  int sl_prev=0,sl_cur=0,sl_next=SLOTB;
  #define ROT() do{sl_prev=sl_cur;sl_cur=sl_next;sl_next=(sl_next==(NSLOT-1)*SLOTB)?0:sl_next+SLOTB;}while(0)
  DMA_K(2,2*SLOTB);
  WAIT_BAR(3);
  qkt(pA0,pA1,Kbase,qr,negm,r32,hi);asm volatile("s_nop 15\n\ts_nop 7":"+v"(pA0),"+v"(pA1));CMASK(pA0,pA1,0);
  START(pA0,pA1);
  _Pragma("unroll") for(int r=0;r<16;++r)pA1[r]=__builtin_amdgcn_exp2f(pA1[r]);
  WAIT_BAR(0);
  DMA_K(3,0);DMA_V(1,SLOTB);
  ROT();
  kload8(kf,kp0+sl_cur);
  WAIT_BAR(2);
  s16x4 vlo[8],vhi[8]; u32x4 pw0,pw1,pw2,pw3;
  #define PKW(P,B) cvtpk_s(P[B],P[B+1])
  #define PAF(k) __builtin_bit_cast(bf16x8,pw##k)
  #define VFR(i) (bf16x8){vlo[i][0],vlo[i][1],vlo[i][2],vlo[i][3],vhi[i][0],vhi[i][1],vhi[i][2],vhi[i][3]}
  #define PIN(x) asm volatile("":"+v"(x))
  #define MX3(a,b,c) __builtin_fmaxf(__builtin_fmaxf((a),(b)),(c))
  #define GAPA(MF,A0,A1,A2,A3,W0,W1,PW) do{ MF; sacc+=A0; sacc+=A1; sacc+=A2; sacc+=A3; PIN(sacc); W0; W1; PIN(PW); SBAR(); }while(0)
  #define EX(v) __builtin_amdgcn_exp2f(v)
  #define GAPB(MF,X,B) do{ MF; X[B]=EX(X[B]); X[B+1]=EX(X[B+1]); X[B+2]=EX(X[B+2]); X[B+3]=EX(X[B+3]); PIN(X); SBAR(); }while(0)
  #define VRD(i) do{ vlo[i]=vtr(vp_+(((i)>>2)*4096+((i)&3)*1024)); vhi[i]=vtr(vp_+(((i)>>2)*4096+((i)&3)*1024+512)); }while(0)
  #define KRD(G,j) do{ if(G){ kload2(kf,kp0+sl_next,j); SBAR(); } }while(0)
  #define STEP(C0,C1,P0,P1,t,GK,GV,GL) do{ SBAR(); \
    const lds_cptr vp_=vp0+sl_prev; \
    VRD(0); SBAR(); float sacc=(P0[0]+P0[1]); \
    GAPA(C0=__builtin_amdgcn_mfma_f32_32x32x16_bf16(kf[0],qr[0],negm,0,0,0), P0[2],P0[3],P0[4],P0[5],     pw0[0]=PKW(P0,0), pw0[1]=PKW(P0,2), pw0); \
    VRD(4); SBAR(); GAPA(C1=__builtin_amdgcn_mfma_f32_32x32x16_bf16(kf[1],qr[0],negm,0,0,0), P0[6],P0[7],P0[8],P0[9],     pw0[2]=PKW(P0,4), pw0[3]=PKW(P0,6), pw0); \
    VRD(1); SBAR(); GAPA(C0=__builtin_amdgcn_mfma_f32_32x32x16_bf16(kf[2],qr[1],C0,0,0,0),   P0[10],P0[11],P0[12],P0[13], pw1[0]=PKW(P0,8), pw1[1]=PKW(P0,10), pw1); \
    VRD(5); SBAR(); GAPA(C1=__builtin_amdgcn_mfma_f32_32x32x16_bf16(kf[3],qr[1],C1,0,0,0),   P0[14],P0[15],P1[0],P1[1],   pw1[2]=PKW(P0,12),pw1[3]=PKW(P0,14), pw1); \
    VRD(2); SBAR(); GAPA(C0=__builtin_amdgcn_mfma_f32_32x32x16_bf16(kf[4],qr[2],C0,0,0,0),   P1[2],P1[3],P1[4],P1[5],     pw2[0]=PKW(P1,0), pw2[1]=PKW(P1,2), pw2); \
    VRD(6); SBAR(); GAPA(C1=__builtin_amdgcn_mfma_f32_32x32x16_bf16(kf[5],qr[2],C1,0,0,0),   P1[6],P1[7],P1[8],P1[9],     pw2[2]=PKW(P1,4), pw2[3]=PKW(P1,6), pw2); \
    VRD(3); SBAR(); GAPA(C0=__builtin_amdgcn_mfma_f32_32x32x16_bf16(kf[6],qr[3],C0,0,0,0),   P1[10],P1[11],P1[12],P1[13], pw3[0]=PKW(P1,8), pw3[1]=PKW(P1,10), pw3); \
    VRD(7); SBAR(); GAPA(C1=__builtin_amdgcn_mfma_f32_32x32x16_bf16(kf[7],qr[3],C1,0,0,0),   P1[14],P1[15],0.f,0.f,       pw3[2]=PKW(P1,12),pw3[3]=PKW(P1,14), pw3); \
    l_reg+=sacc; \
    if(GK){DMA_K((t)+3,sl_cur);} if(GV){DMA_V((t)+1,sl_next);} \
    CMASK(C0,C1,t); \
    if constexpr(!NOMAX){ _Pragma("unroll") for(int r=0;r<16;++r){C0[r]-=mhat;C1[r]-=mhat;} \
    { float a=MX3(C0[0],C0[1],C1[0]),b=MX3(C0[2],C0[3],C1[1]); a=MX3(a,C1[2],C1[3]); \
      _Pragma("unroll") for(int r=4;r<16;r+=4){a=MX3(a,C0[r],C0[r+1]);b=MX3(b,C0[r+2],C0[r+3]);a=MX3(a,C1[r],C1[r+1]);b=MX3(b,C1[r+2],C1[r+3]);} \
      float rm=__builtin_fmaxf(a,b); { auto rr=__builtin_amdgcn_permlane32_swap(__float_as_uint(rm),__float_as_uint(rm),false,false); rm=__builtin_fmaxf(__uint_as_float(rr[0]),__uint_as_float(rr[1])); } \
      resc=false; \
      if(__builtin_expect(__any(rm>(float)THRL),0)){ const float dl=__builtin_fmaxf(rm,0.f); mhat+=dl; \
        _Pragma("unroll") for(int r=0;r<16;++r){C0[r]-=dl;C1[r]-=dl;} \
        const float f=__builtin_amdgcn_exp2f(-dl); l_reg*=f; if(hi==0)wsf[r32]=f; resc=true; } } } \
    SBAR(); \
    GAPB(o[0]=__builtin_amdgcn_mfma_f32_32x32x16_bf16(PAF(0),VFR(0),o[0],0,0,0), C0,0); \
    GAPB(o[1]=__builtin_amdgcn_mfma_f32_32x32x16_bf16(PAF(0),VFR(4),o[1],0,0,0), C0,4); \
    KRD(GL,0); GAPB(o[0]=__builtin_amdgcn_mfma_f32_32x32x16_bf16(PAF(1),VFR(1),o[0],0,0,0), C0,8); \
    KRD(GL,1); GAPB(o[1]=__builtin_amdgcn_mfma_f32_32x32x16_bf16(PAF(1),VFR(5),o[1],0,0,0), C0,12); \
    KRD(GL,2); GAPB(o[0]=__builtin_amdgcn_mfma_f32_32x32x16_bf16(PAF(2),VFR(2),o[0],0,0,0), C1,0); \
    KRD(GL,3); GAPB(o[1]=__builtin_amdgcn_mfma_f32_32x32x16_bf16(PAF(2),VFR(6),o[1],0,0,0), C1,4); \
    GAPB(o[0]=__builtin_amdgcn_mfma_f32_32x32x16_bf16(PAF(3),VFR(3),o[0],0,0,0), C1,8); \
    GAPB(o[1]=__builtin_amdgcn_mfma_f32_32x32x16_bf16(PAF(3),VFR(7),o[1],0,0,0), C1,12); \
    }while(0)
  int t=1;
  for(;t+5<NT;t+=2){
    STEP(pB0,pB1,pA0,pA1,t,true,true,true);     WAIT_BAR(2); RESC(); ROT();
    STEP(pA0,pA1,pB0,pB1,t+1,true,true,true);   WAIT_BAR(2); RESC(); ROT();
  }
  #undef CMASK
  #define CMASK(P0,P1,t) do{}while(0)
  #define ENDW(tt) do{ if((tt)+3<NT){WAIT_BAR(2);} else if((tt)+2<NT){WAIT_BAR(1);} else {WAIT_BAR(0);} }while(0)
  for(;t+1<NT;t+=2){
    STEP(pB0,pB1,pA0,pA1,t,(t+3<NT),(t+1<NT),(t+1<NT));       ENDW(t);   RESC(); ROT();
    STEP(pA0,pA1,pB0,pB1,t+1,(t+4<NT),(t+2<NT),(t+2<NT));     ENDW(t+1); RESC(); ROT();
  }
  STEP(pB0,pB1,pA0,pA1,NT-1,false,false,false); RESC();
  { float sacc=pB0[0]+pB0[1]; _Pragma("unroll") for(int r=2;r<16;++r)sacc+=pB0[r]; _Pragma("unroll") for(int r=0;r<16;++r)sacc+=pB1[r]; l_reg+=sacc;
    pw0=(u32x4){PKW(pB0,0),PKW(pB0,2),PKW(pB0,4),PKW(pB0,6)};pw1=(u32x4){PKW(pB0,8),PKW(pB0,10),PKW(pB0,12),PKW(pB0,14)};pw2=(u32x4){PKW(pB1,0),PKW(pB1,2),PKW(pB1,4),PKW(pB1,6)};pw3=(u32x4){PKW(pB1,8),PKW(pB1,10),PKW(pB1,12),PKW(pB1,14)};
    SBAR(); pv(o,vb0+sl_cur,PAF(0),PAF(1),PAF(2),PAF(3)); }
  #undef PKW
  #undef PAF
  #undef VFR
  #undef PIN
  #undef MX3
  #undef GAPA
  #undef GAPB
  #undef EX
  #undef VRD
  #undef KRD
  #undef STEP
  #undef ENDW
  {auto rr=__builtin_amdgcn_permlane32_swap(__float_as_uint(l_reg),__float_as_uint(l_reg),false,false);l_reg=__uint_as_float(rr[0])+__uint_as_float(rr[1]);}
  if(hi==0)wsf[32+r32]=l_reg;asm volatile("s_waitcnt lgkmcnt(0)":::"memory");
  float rli[16];
  #pragma unroll
  for(int r=0;r<16;++r)rli[r]=__builtin_amdgcn_rcpf(wsf[32+crow(r,hi)]);
  bf16*Ow=O+(qrow0+wid*QBLK)*QP+h*D;
  { bf16*stg=(bf16*)(shm+LDS_OST)+wid*2048;
    #pragma unroll
    for(int r=0;r<16;++r){const int orow=crow(r,hi);
      #pragma unroll
      for(int d0=0;d0<2;++d0)stg[orow*64+d0*32+r32]=f2bf(o[d0][r]*rli[r]);}
    asm volatile("s_waitcnt lgkmcnt(0)":::"memory");
    #pragma unroll
    for(int i=0;i<4;++i){const int row=i*8+(lane>>3),ch=lane&7; const u32x4 v=*(const u32x4*)(stg+row*64+ch*8); ATTN_STORE16(Ow+(long)row*QP+ch*8,v);} }
  asm volatile("s_waitcnt lgkmcnt(0)\n\ts_barrier":::"memory");
  #undef DMA_K
  #undef DMA_V
  #undef CMASK
  #undef START
  #undef RESC
  #undef ROT
}
constexpr int ATTN_LDS_BYTES=LDS_BYTES;
#undef SBAR
#undef WAIT_BAR
}

struct Args { const float* in[29]; float* out; unsigned char* ws; int ph_lo, ph_hi; };
typedef const __attribute__((address_space(4))) struct Args* KArgs;
struct Frame {
    LAS unsigned char* lds; float* out; unsigned char* ws; KArgs ka;
    int tid, lane, wave, vcu, G, bx;
    int aff, xx, xr, xn;
};
#define IN(k) ((const float*)(GAS const float*)(F.ka->in[k]))
__device__ __forceinline__ int tid_now(int wave) { unsigned z = 0u; asm volatile("" : "+s"(z)); return (wave << 6) | (int)__builtin_amdgcn_mbcnt_hi(~0u, __builtin_amdgcn_mbcnt_lo(~0u, z)); }
__device__ __forceinline__ float modv(const Args& A, const Frame& F, int l, int bi, int n) {
    const float* P = (const float*)(F.ws + OFF_MODP); const int i = (l * 9 + bi) * 6144 + n;
    return P[i] + P[4 * 9 * 6144 + i] + IN(5)[l * 6144 + n];
}
__device__ __forceinline__ void transpose_item(const float* W, int K, int N, bf16_t* WT, LAS float* scr, int item, int lane) {
    const int nblk = N / 64, kb = item / nblk, nb = item % nblk, k0 = 64 * kb, n0 = 64 * nb;
#pragma unroll 16
    for (int i = 0; i < 64; ++i) scr[i * 65 + lane] = W[(size_t)(k0 + i) * N + n0 + lane];
    asm volatile("s_waitcnt lgkmcnt(0)" ::: "memory");
    const int c = lane & 7;
#pragma unroll
    for (int jj = 0; jj < 8; ++jj) { const int n = (lane >> 3) + 8 * jj; const LAS float* s = scr + (8 * c) * 65 + n;
        u32x4 o; o.x = cvt_pk_bf16(s[0], s[65]); o.y = cvt_pk_bf16(s[2 * 65], s[3 * 65]); o.z = cvt_pk_bf16(s[4 * 65], s[5 * 65]); o.w = cvt_pk_bf16(s[6 * 65], s[7 * 65]);
        *(u32x4*)(WT + (size_t)(n0 + n) * K + k0 + 8 * c) = o; }
    asm volatile("s_waitcnt lgkmcnt(0)" ::: "memory");
}
__device__ __forceinline__ void phase_pro0(const Args& A, Frame& F) {
    const float* c = IN(1); const float* c_ctx = IN(3); const float* mod_w = IN(4);
    {
        LAS float* scond = (LAS float*)F.lds;
        LAS float* red = (LAS float*)(F.lds + 9 * 512 * 4);
        float* MODP = (float*)(F.ws + OFF_MODP);
        for (int u = F.bx; u < 4 * 48 * 2; u += F.G) {
            const int kh = u & 1, cc = (u >> 1) % 48, l = (u >> 1) / 48, n0 = 128 * cc;
            __syncthreads();
            for (int i = F.tid; i < 9 * 512; i += NTHR) { const int bi = i >> 9, k = i & 511; const float x = bi < 8 ? c[bi * D + kh * 512 + k] : c_ctx[kh * 512 + k]; scond[i] = x / (1.f + expf(-x)); }
            __syncthreads();
            float a0[9], a1[9];
#pragma unroll
            for (int b = 0; b < 9; ++b) { a0[b] = 0.f; a1[b] = 0.f; }
            const float* wp = mod_w + ((size_t)l * D + kh * 512 + F.wave * 64) * 6144 + n0 + 2 * F.lane;
#pragma unroll 8
            for (int kk = 0; kk < 64; ++kk) { const f32x2 w = *(const f32x2*)(wp + (size_t)kk * 6144);
#pragma unroll
                for (int b = 0; b < 9; ++b) { const float s = scond[b * 512 + F.wave * 64 + kk]; a0[b] += s * w.x; a1[b] += s * w.y; } }
#pragma unroll
            for (int b = 0; b < 9; ++b) { red[(F.wave * 9 + b) * 128 + 2 * F.lane] = a0[b]; red[(F.wave * 9 + b) * 128 + 2 * F.lane + 1] = a1[b]; }
            __syncthreads();
            for (int i = F.tid; i < 9 * 128; i += NTHR) { const int b = i >> 7, col = i & 127; float s = 0.f;
#pragma unroll
                for (int w = 0; w < 8; ++w) s += red[(w * 9 + b) * 128 + col];
                MODP[(size_t)kh * 4 * 9 * 6144 + (l * 9 + b) * 6144 + n0 + col] = s; }
        }
        __syncthreads();
    }
    {
        float* rope = (float*)(F.ws + OFF_ROPE); float* sp = (float*)(F.ws + OFF_SP);
        const int gt = F.bx * NTHR + F.tid;
        if (gt < 1024) { const int pos = gt >> 4, f = gt & 15; const float inv = powf(10000.f, -(float)f / 16.f), ang = (float)pos * inv; rope[gt] = cosf(ang); rope[1024 + gt] = sinf(ang); }
        else if (gt < 1024 + 2048) { const int i = gt - 1024; sp[i] = log1pf(expf(-IN(27)[i])); }
    }
    {
        LAS float* scr = (LAS float*)(F.lds + F.wave * 16640);
        bf16_t* WT = (bf16_t*)(F.ws + OFF_WT);
        const int gw = F.vcu * NWAVES + F.wave, NGW = F.G * NWAVES;
        constexpr int I_W1 = 16 * 64, I_W2 = 64 * 16, I_QKV = 16 * 24, I_SQ = 16 * 16, I_2K = 16 * 32;
        constexpr int NITEMS = 4 * I_W1 + 4 * I_W2 + 2 * I_QKV + 2 * I_SQ + I_2K + I_SQ + I_2K + I_SQ;
        for (int it = gw; it < NITEMS; it += NGW) {
            int r = it;
            if (r < 4 * I_W1) { const int l = r / I_W1; transpose_item(IN(8) + (size_t)l * D * DFF, D, DFF, WT + WT_W1 + (size_t)l * D * DFF, scr, r % I_W1, F.lane); continue; } r -= 4 * I_W1;
            if (r < 4 * I_W2) { const int l = r / I_W2; transpose_item(IN(9) + (size_t)l * D * DFF, DFF, D, WT + WT_W2 + (size_t)l * D * DFF, scr, r % I_W2, F.lane); continue; } r -= 4 * I_W2;
            if (r < 2 * I_QKV) { const int j = r / I_QKV; transpose_item(IN(10) + (size_t)j * D * 1536, D, 1536, WT + WT_QKV + (size_t)j * D * 1536, scr, r % I_QKV, F.lane); continue; } r -= 2 * I_QKV;
            if (r < 2 * I_SQ) { const int j = r / I_SQ; transpose_item(IN(13) + (size_t)j * D * D, D, D, WT + WT_WO + (size_t)j * D * D, scr, r % I_SQ, F.lane); continue; } r -= 2 * I_SQ;
            if (r < I_2K) { transpose_item(IN(14), D, 2048, WT + WT_CIN, scr, r, F.lane); continue; } r -= I_2K;
            if (r < I_SQ) { transpose_item(IN(20), D, D, WT + WT_COUT, scr, r, F.lane); continue; } r -= I_SQ;
            if (r < I_2K) { transpose_item(IN(22), D, 2048, WT + WT_LIN, scr, r, F.lane); continue; } r -= I_2K;
            transpose_item(IN(28), D, D, WT + WT_LOUT, scr, r, F.lane);
        }
    }
}
__device__ __forceinline__ void phase_pro1(const Args& A, Frame& F) {
    {
        float* MODF = (float*)(F.ws + OFF_MODF); float* GAIN = (float*)(F.ws + OFF_GAIN);
        const int NT1 = 4 * 9 * 6144, NT2 = 4 * 2 * 9 * 1024;
        for (int i = F.bx * NTHR + F.tid; i < NT1 + NT2; i += F.G * NTHR) {
            if (i < NT1) { const int n = i % 6144, bi = (i / 6144) % 9, l = i / (6144 * 9); MODF[i] = modv(A, F, l, bi, n); }
            else { const int e = i - NT1, k = e & 1023, bi = (e >> 10) % 9, w = (e / 9216) & 1, l = e / 18432;
                GAIN[e] = (w ? IN(7) : IN(6))[l * D + k] * (1.f + modv(A, F, l, bi, (3 * w + 1) * D + k)); }
        }
    }
    {
        LAS bf16_t* shb = (LAS bf16_t*)F.lds;
        constexpr int SHP = 1024 + 8;
        float* SW = (float*)(F.ws + OFF_SW); const bf16_t* WT = (const bf16_t*)(F.ws + OFF_WT);
        constexpr int U_MLP = DFF / 128, U_QKV = 1536 / 128, U_2K = 2048 / 128, NU = 4 * U_MLP + 2 * U_QKV + 2 * U_2K;
        for (int u = F.bx; u < NU; u += F.G) {
            int r = u, l, w, N, cb; const bf16_t* Wt; const float* bias = nullptr; float* dst;
            if (r < 4 * U_MLP) { l = r / U_MLP; cb = r % U_MLP; w = 1; N = DFF; Wt = WT + WT_W1 + (size_t)l * D * DFF; dst = SW + SW_MLP + l * 9 * DFF; }
            else { r -= 4 * U_MLP;
                if (r < 2 * U_QKV) { const int j = r / U_QKV; l = 3 * j; cb = r % U_QKV; w = 0; N = 1536; Wt = WT + WT_QKV + (size_t)j * D * 1536; dst = SW + SW_QKV + j * 9 * 1536; }
                else { r -= 2 * U_QKV;
                    if (r < U_2K) { l = 1; cb = r; w = 0; N = 2048; Wt = WT + WT_CIN; bias = IN(15); dst = SW + SW_CIN; }
                    else { r -= U_2K; l = 2; cb = r; w = 0; N = 2048; Wt = WT + WT_LIN; dst = SW + SW_LIN; } } }
            __syncthreads();
            for (int i = F.tid; i < 16 * 1024; i += NTHR) { const int bi = i >> 10, k = i & 1023; shb[bi * SHP + k] = bi < 9 ? f2bf(modv(A, F, l, bi, (3 * w) * D + k)) : (bf16_t)0; }
            __syncthreads();
            const int n0 = cb * 128 + F.wave * 16, fr = F.lane & 15, fq = F.lane >> 4;
            const bf16_t* bp = Wt + (size_t)(n0 + fr) * D + 8 * fq;
            const LAS bf16_t* ap = shb + fr * SHP + 8 * fq;
            f32x4 acc = {0.f, 0.f, 0.f, 0.f};
            bf16x8 bfr[32];
#pragma unroll
            for (int ks = 0; ks < 32; ++ks) bfr[ks] = *(const bf16x8*)(bp + 32 * ks);
#pragma unroll
            for (int ks = 0; ks < 32; ++ks) acc = __builtin_amdgcn_mfma_f32_16x16x32_bf16(*(const LAS bf16x8*)(ap + 32 * ks), bfr[ks], acc, 0, 0, 0);
            const float bv = bias ? bias[n0 + fr] : 0.f;
#pragma unroll
            for (int rg = 0; rg < 4; ++rg) { const int bi = 4 * fq + rg; if (bi < 9) dst[bi * N + n0 + fr] = acc[rg] + bv; }
        }
        __syncthreads();
    }
    {
        LAS float* g0 = (LAS float*)F.lds;
        for (int i = F.tid; i < 9 * 1024; i += NTHR) g0[i] = IN(6)[i & 1023] * (1.f + modv(A, F, 0, i >> 10, D + (i & 1023)));
        __syncthreads();
        bf16_t* XG = (bf16_t*)(F.ws + OFF_XG); float* SSQ = (float*)(F.ws + OFF_SSQ);
        const int gw = F.vcu * NWAVES + F.wave, NGW = F.G * NWAVES;
        f32x4 nv[4];
#define XG0_LOAD(row_) do { const float* src_ = (row_) < ML ? IN(0) + (size_t)(row_) * D : IN(2) + (size_t)((row_) - ML) * D; \
            _Pragma("unroll") for (int j = 0; j < 4; ++j) nv[j] = ((const f32x4*)src_)[64 * j + F.lane]; } while (0)
        if (gw < M) XG0_LOAD(gw);
        for (int row = gw; row < M; row += NGW) {
            f32x4 v4[4];
#pragma unroll
            for (int j = 0; j < 4; ++j) v4[j] = nv[j];
            if (row + NGW < M) XG0_LOAD(row + NGW);
            const int bi = row < ML ? (row >> 11) : 8;
            float ss = 0.f;
#pragma unroll
            for (int j = 0; j < 4; ++j) { const f32x4 v = v4[j];
                ss += (v[0] * v[0] + v[1] * v[1]) + (v[2] * v[2] + v[3] * v[3]);
                const f32x4 gv = *(const LAS f32x4*)(g0 + bi * 1024 + 256 * j + 4 * F.lane);
                u32x2 w; w.x = cvt_pk_bf16(v[0] * gv[0], v[1] * gv[1]); w.y = cvt_pk_bf16(v[2] * gv[2], v[3] * gv[3]);
                *(u32x2*)(XG + (size_t)row * D + 256 * j + 4 * F.lane) = w; }
            ss = wave_sum(ss, F.lane);
            if (F.lane < 16) SSQ[(size_t)row * 16 + F.lane] = F.lane == 0 ? ss : 0.f;
        }
#undef XG0_LOAD
        __syncthreads();
    }
}

__device__ __forceinline__ void attn_phase(const Frame& F, char* lds_gen, bool lat_only) {
    bool nomax;
    { const int j = lat_only ? 1 : 0; float gq = fabsf(IN(11)[j * 64 + F.lane]), gk = fabsf(IN(12)[j * 64 + F.lane]);
#pragma unroll
      for (int m = 1; m < 64; m <<= 1) { gq = fmaxf(gq, shx(gq, m, F.lane)); gk = fmaxf(gk, shx(gk, m, F.lane)); }
      const float bound = 8.f * 1.4426950408889634f * 1.02f * gq * gk;
      nomax = __builtin_amdgcn_readfirstlane((int)(bound <= 64.f)) != 0; }
    const bf16_t* Q = (const bf16_t*)(F.ws + OFF_R1); bf16_t* O = (bf16_t*)(F.ws + OFF_R2);
    const bf16_t* Kb = (const bf16_t*)(F.ws + OFF_KV); const bf16_t* Vb = Kb + (size_t)BATCH * TKV * 256;
    const int total = lat_only ? 1024 : 1152, x = F.vcu >> 5, i = F.vcu & 31;
    for (int k = 0;; ++k) {
        int L;
        if (F.aff) { const int idx = k * F.xn + F.xr; L = idx < 128 ? F.xx * 128 + idx : (!lat_only && idx < 144) ? 1024 + F.xx * 16 + (idx - 128) : -1; }
        else if (F.G == 256) L = k < 4 ? x * 128 + k * 32 + i : (k == 4 && i < 16 && !lat_only) ? 1024 + x * 16 + i : -1;
        else { L = F.vcu + k * F.G; if (L >= total) L = -1; }
        if (L < 0) break;
        long qrow0, kvrow0; int h, NT;
        if (L < 1024) { const int b = L >> 7, kvh = (L >> 5) & 3, g = (L >> 3) & 3, qb = L & 7; h = kvh * 4 + g; qrow0 = (long)b * SEQ + qb * 256; kvrow0 = (long)b * TKV; NT = TKV / 64; }
        else { const int uc = L - 1024, b = uc >> 4; h = uc & 15; qrow0 = (long)ML + b * CTXL; kvrow0 = (long)b * TKV; NT = CTXL / 64; }
        if (nomax) attn_body::attn_unit<8, true>(F.tid, qrow0, h, kvrow0, NT, Q, Kb, Vb, O, lds_gen);
        else attn_body::attn_unit<8, false>(F.tid, qrow0, h, kvrow0, NT, Q, Kb, Vb, O, lds_gen);
    }
}
__device__ __forceinline__ void conv31_phase(const Args& A, const Frame& F) {
    const bf16_t* U = (const bf16_t*)(F.ws + OFF_R1); bf16_t* Y = (bf16_t*)(F.ws + OFF_R2);
    const int c0 = 2 * F.tid;
    f32x2 w[31];
#pragma unroll
    for (int k = 0; k < 31; ++k) w[k] = *(const f32x2*)(IN(16) + k * D + c0);
    const f32x2 bdw = *(const f32x2*)(IN(17) + c0), ng = *(const f32x2*)(IN(18) + c0), nb = *(const f32x2*)(IN(19) + c0);
    LAS float* red = (LAS float*)F.lds;
    LAS float* tot = (LAS float*)(F.lds + 1024);
    unsigned pks[46];
#define C31_LOAD(unit_) do { const int row0_ = (unit_) * 16; const int base_ = row0_ < ML ? (row0_ & ~(SEQ - 1)) : ML + ((row0_ - ML) & ~(CTXL - 1)), L_ = row0_ < ML ? SEQ : CTXL, t0_ = row0_ - base_; \
        _Pragma("unroll") for (int ir = 0; ir < 46; ++ir) { const int tt = t0_ + ir - 15, tc = tt < 0 ? 0 : (tt >= L_ ? L_ - 1 : tt); pks[ir] = *(const unsigned*)(U + (size_t)(base_ + tc) * D + c0); } } while (0)
    const int k0 = F.aff ? F.xr : F.bx, kstep = F.aff ? F.xn : F.G, kend = F.aff ? 144 : M / 16;
#define C31_UNIT(k_) (F.aff ? ((k_) < 128 ? F.xx * 128 + (k_) : 1024 + F.xx * 16 + ((k_) - 128)) : (k_))
    if (k0 < kend) C31_LOAD(C31_UNIT(k0));
    for (int kk = k0; kk < kend; kk += kstep) { const int unit = C31_UNIT(kk);
        const int row0 = unit * 16;
        const int base = row0 < ML ? (row0 & ~(SEQ - 1)) : ML + ((row0 - ML) & ~(CTXL - 1)), L = row0 < ML ? SEQ : CTXL, t0 = row0 - base;
        f32x2 acc[16];
#pragma unroll
        for (int tr = 0; tr < 16; ++tr) acc[tr] = bdw;
#pragma unroll
        for (int ir = 0; ir < 46; ++ir) {
            const int tt = t0 + ir - 15;
            const unsigned pk = (tt >= 0 && tt < L) ? pks[ir] : 0u;
            const f32x2 xv = {__uint_as_float(pk << 16), __uint_as_float(pk & 0xffff0000u)};
#pragma unroll
            for (int tr = 0; tr < 16; ++tr) { const int k = ir - tr; if (k >= 0 && k <= 30) acc[tr] += w[k] * xv; }
        }
        asm volatile("" ::: "memory");
        if (kk + kstep < kend) C31_LOAD(C31_UNIT(kk + kstep));
#pragma unroll
        for (int tr = 0; tr < 16; ++tr) {
            const float sv = wave_sum(acc[tr].x + acc[tr].y, F.lane), qv = wave_sum(acc[tr].x * acc[tr].x + acc[tr].y * acc[tr].y, F.lane);
            if (F.lane == 0) { red[F.wave * 32 + tr] = sv; red[F.wave * 32 + 16 + tr] = qv; }
        }
        asm volatile("s_waitcnt lgkmcnt(0)" ::: "memory"); __builtin_amdgcn_s_barrier(); asm volatile("" ::: "memory");
        if (F.tid < 32) { float v = 0.f;
#pragma unroll
            for (int ww = 0; ww < 8; ++ww) v += red[ww * 32 + F.tid];
            tot[F.tid] = v; }
        asm volatile("s_waitcnt lgkmcnt(0)" ::: "memory"); __builtin_amdgcn_s_barrier(); asm volatile("" ::: "memory");
#pragma unroll
        for (int tr = 0; tr < 16; ++tr) {
            const float mean = tot[tr] * (1.f / D), var = tot[16 + tr] * (1.f / D) - mean * mean, rstd = rsqrtf(var + EPS);
            const float y0 = (acc[tr].x - mean) * rstd * ng.x + nb.x, y1 = (acc[tr].y - mean) * rstd * ng.y + nb.y;
            *(unsigned*)(Y + (size_t)(row0 + tr) * D + c0) = cvt_pk_bf16(y0 * fast_sigmoid(y0), y1 * fast_sigmoid(y1));
        }
    }
#undef C31_LOAD
#undef C31_UNIT
    __syncthreads();
}
__device__ __forceinline__ void conv4_phase(const Args& A, const Frame& F) {
    const bf16_t* XB = (const bf16_t*)(F.ws + OFF_R2);
    bf16_t* UF = (bf16_t*)(F.ws + OFF_BIG + 72 * MiB); bf16_t* UB = (bf16_t*)(F.ws + OFF_BIG + 108 * MiB);
    const int gthreads = (F.aff ? F.xn : F.G) * NTHR, gid = (F.aff ? F.xr : F.bx) * NTHR + F.tid;
    const int iend = F.aff ? 288 * 128 : (M / 8) * 128;
    const int cg = gid & 127, c0 = 8 * cg;
    f32x4 wf[4][2], wb[4][2], bf_[2], bb_[2];
#pragma unroll
    for (int k = 0; k < 4; ++k)
#pragma unroll
        for (int hh = 0; hh < 2; ++hh) { wf[k][hh] = *(const f32x4*)(IN(23) + (0 * 4 + k) * D + c0 + 4 * hh); wb[k][hh] = *(const f32x4*)(IN(23) + (1 * 4 + k) * D + c0 + 4 * hh); }
#pragma unroll
    for (int hh = 0; hh < 2; ++hh) { bf_[hh] = *(const f32x4*)(IN(24) + c0 + 4 * hh); bb_[hh] = *(const f32x4*)(IN(24) + D + c0 + 4 * hh); }
    for (int idx = gid; idx < iend; idx += gthreads) {
        const int blk_ = idx >> 7, r0 = (F.aff ? (blk_ < 256 ? F.xx * 256 + blk_ : 2048 + F.xx * 32 + (blk_ - 256)) : blk_) * 8;
        u32x4 p[14];
#pragma unroll
        for (int i = 0; i < 14; ++i) { int rr = r0 - 3 + i; rr = rr < 0 ? 0 : (rr > M - 1 ? M - 1 : rr); p[i] = *(const u32x4*)(XB + (size_t)rr * D + c0); }
#pragma unroll
        for (int o = 0; o < 8; ++o) {
            const int row = r0 + o;
            const int t = row < ML ? (row & (SEQ - 1)) : ((row - ML) & (CTXL - 1)), L = row < ML ? SEQ : CTXL;
            f32x4 vf[2] = {bf_[0], bf_[1]}, vb[2] = {bb_[0], bb_[1]};
#pragma unroll
            for (int dt = 0; dt < 7; ++dt) { const int tt = t + dt - 3;
                if (tt >= 0 && tt < L) { const u32x4 q = p[o + dt];
                    const f32x4 x0 = {__uint_as_float(q.x << 16), __uint_as_float(q.x & 0xffff0000u), __uint_as_float(q.y << 16), __uint_as_float(q.y & 0xffff0000u)};
                    const f32x4 x1 = {__uint_as_float(q.z << 16), __uint_as_float(q.z & 0xffff0000u), __uint_as_float(q.w << 16), __uint_as_float(q.w & 0xffff0000u)};
                    if (dt <= 3) { vf[0] += wf[dt][0] * x0; vf[1] += wf[dt][1] * x1; }
                    if (dt >= 3) { vb[0] += wb[6 - dt][0] * x0; vb[1] += wb[6 - dt][1] * x1; } } }
            u32x4 of, ob;
            of.x = cvt_pk_bf16(vf[0][0], vf[0][1]); of.y = cvt_pk_bf16(vf[0][2], vf[0][3]); of.z = cvt_pk_bf16(vf[1][0], vf[1][1]); of.w = cvt_pk_bf16(vf[1][2], vf[1][3]);
            ob.x = cvt_pk_bf16(vb[0][0], vb[0][1]); ob.y = cvt_pk_bf16(vb[0][2], vb[0][3]); ob.z = cvt_pk_bf16(vb[1][0], vb[1][1]); ob.w = cvt_pk_bf16(vb[1][2], vb[1][3]);
            *(u32x4*)(UF + (size_t)row * D + c0) = of; *(u32x4*)(UB + (size_t)row * D + c0) = ob;
        }
    }
}
typedef float f32x16 __attribute__((ext_vector_type(16)));
template <int DIR>
__device__ __forceinline__ void lru_dir(const Frame& F, int b, int n, int sl) {
    const int lane = F.lane, w = F.wave, col = lane & 31, hi = lane >> 5;
    const int ch = 256 * n + 32 * sl + col;
    const bf16_t* U = (const bf16_t*)(F.ws + OFF_BIG + (DIR ? 108 : 72) * MiB);
    float* HF = (float*)(F.ws + OFF_BIG); const bf16_t* Gb = (const bf16_t*)(F.ws + OFF_R1); bf16_t* Y = (bf16_t*)(F.ws + OFF_R2);
    LAS unsigned char* WL = F.lds;
    LAS f32x2* CAR = (LAS f32x2*)(F.lds + 34816);
    __syncthreads();
    { const float* gw = IN(25);
#pragma unroll 1
      for (int e0 = 0; e0 < 32; e0 += 16) { float wv[16];
#pragma unroll
        for (int e = 0; e < 16; ++e) { const int idx = F.tid + NTHR * (e0 + e), g = idx >> 13, k = (idx >> 5) & 255, c = idx & 31;
            wv[e] = gw[((size_t)((DIR * 2 + g) * 4 + n) * 256 + k) * 256 + 32 * sl + c]; }
#pragma unroll
        for (int e = 0; e < 16; ++e) { const int idx = F.tid + NTHR * (e0 + e), g = idx >> 13, k = (idx >> 5) & 255, c = idx & 31;
            *(LAS bf16_t*)(WL + (g * 32 + c) * 528 + k * 2) = f2bf(wv[e]); } } }
    __syncthreads();
    const float br = IN(26)[(DIR * 2 + 0) * D + ch], bi = IN(26)[(DIR * 2 + 1) * D + ch];
    const float spv = ((const float*)(F.ws + OFF_SP))[DIR * D + ch] * (-8.f * 1.4426950408889634f);
    const unsigned vo_p = (unsigned)((lane >> 4) * D + 8 * (lane & 15)) * 2u;
    LAS unsigned char* AS = F.lds + 40960 + w * 8704;
    const unsigned vo_e = (unsigned)(4 * hi * D + col);
    float Hrun = 0.f;
    u32x4 pf[2][8];
#define LRU_ROW0(step_) ((step_) == 0 ? ML + b * CTXL : b * SEQ + 256 * (DIR ? 8 - (step_) : (step_) - 1))
#define LRU_UOFF(row0_, r_) ((size_t)((row0_) + 32 * w + ((r_) & 3) + 8 * ((r_) >> 2)) * D + 256 * n + 32 * sl)
#define LRU_PREFETCH(step_, hf_) do { const int row0_ = LRU_ROW0(step_); \
        const bf16_t* ua_ = U + (size_t)(row0_ + 32 * w) * D + 256 * n; \
        _Pragma("unroll") for (int j = 0; j < 8; ++j) pf[hf_][j] = ldu<u32x4>(ua_ + (size_t)(4 * j) * D + 128 * (hf_), vo_p); } while (0)
    LRU_PREFETCH(0, 0); LRU_PREFETCH(0, 1);
    for (int step = 0; step < 9; ++step) {
        const int row0 = LRU_ROW0(step);
        float hfv[16]; bf16_t gv[16];
        if (DIR == 1) {
#pragma unroll
            for (int r = 0; r < 16; ++r) { hfv[r] = ldu<float>(HF + LRU_UOFF(row0, r), vo_e * 4u); gv[r] = ldu<bf16_t>(Gb + LRU_UOFF(row0, r), vo_e * 2u); }
        }
        f32x16 ar, ai;
#pragma unroll
        for (int r = 0; r < 16; ++r) { ar[r] = 0.f; ai[r] = 0.f; }
        const LAS unsigned char* wp = WL + col * 528 + 16 * hi;
        bf16_t uc[16];
#pragma unroll
        for (int hf = 0; hf < 2; ++hf) {
#pragma unroll
            for (int j = 0; j < 8; ++j) *(LAS u32x4*)(AS + (4 * j + (lane >> 4)) * 272 + (lane & 15) * 16) = pf[hf][j];
            asm volatile("" ::: "memory");
            if (step + 1 < 9) LRU_PREFETCH(step + 1, hf);
#pragma unroll
            for (int k8 = 0; k8 < 8; ++k8) { const int ks = 8 * hf + k8;
                const bf16x8 af = *(const LAS bf16x8*)(AS + col * 272 + 32 * k8 + 16 * hi);
                const bf16x8 wr = *(const LAS bf16x8*)(wp + 32 * ks), wi = *(const LAS bf16x8*)(wp + 32 * 528 + 32 * ks);
                ar = __builtin_amdgcn_mfma_f32_32x32x16_bf16(af, wr, ar, 0, 0, 0); ai = __builtin_amdgcn_mfma_f32_32x32x16_bf16(af, wi, ai, 0, 0, 0); }
            if (hf == (sl >> 2)) {
#pragma unroll
                for (int r = 0; r < 16; ++r) uc[r] = *(const LAS bf16_t*)(AS + ((r & 3) + 8 * (r >> 2) + 4 * hi) * 272 + ((32 * sl + col) & 127) * 2);
            }
        }
        float a[16], hb[16];
#pragma unroll
        for (int r = 0; r < 16; ++r) {
            const int tk = 32 * w + (r & 3) + 8 * (r >> 2) + 4 * hi;
            const float rr = fast_sigmoid(ar[r] + br), ii = fast_sigmoid(ai[r] + bi);
            const float av = __builtin_amdgcn_exp2f(spv * rr);
            float mult = __builtin_amdgcn_sqrtf(fmaxf(1.f - av * av, 0.f));
            if (step == 0 && tk == (DIR ? 255 : 0)) mult = 1.f;
            a[r] = av; hb[r] = mult * ii * bf2f(uc[r]);
        }
        float Aq[4], Bq[4], pA[4], pB[4];
#pragma unroll
        for (int q = 0; q < 4; ++q) { float H = 0.f, Ac = 1.f;
#pragma unroll
            for (int ee = 0; ee < 4; ++ee) { const int r = 4 * q + (DIR ? 3 - ee : ee); H = a[r] * H + hb[r]; Ac *= a[r]; hb[r] = H; a[r] = Ac; }
            Aq[q] = Ac; Bq[q] = H; pA[q] = shx(Ac, 32, lane); pB[q] = shx(H, 32, lane); }
        float Ac = 1.f, Hc = 0.f, Ain[4], Hin[4];
        const bool mine_first = DIR ? (hi == 1) : (hi == 0);
#pragma unroll
        for (int qq = 0; qq < 4; ++qq) { const int q = DIR ? 3 - qq : qq;
            const float A0 = mine_first ? Aq[q] : pA[q], B0 = mine_first ? Bq[q] : pB[q], A1 = mine_first ? pA[q] : Aq[q], B1 = mine_first ? pB[q] : Bq[q];
            const float i0A = Ac, i0H = Hc; Hc = A0 * Hc + B0; Ac *= A0;
            const float i1A = Ac, i1H = Hc; Hc = A1 * Hc + B1; Ac *= A1;
            Ain[q] = mine_first ? i0A : i1A; Hin[q] = mine_first ? i0H : i1H; }
#pragma unroll
        for (int r = 0; r < 16; ++r) { hb[r] += a[r] * Hin[r >> 2]; a[r] *= Ain[r >> 2]; }
        const int buf = step & 1;
        if (hi == 0) CAR[(buf * 8 + w) * 32 + col] = (f32x2){Ac, Hc};
        asm volatile("s_waitcnt lgkmcnt(0)" ::: "memory"); __builtin_amdgcn_s_barrier(); asm volatile("" ::: "memory");
        float S = Hrun, HinG = 0.f;
#pragma unroll
        for (int jj = 0; jj < 8; ++jj) { const int j = DIR ? 7 - jj : jj; const f32x2 c = CAR[(buf * 8 + j) * 32 + col]; if (j == w) HinG = S; S = c.x * S + c.y; }
        Hrun = S;
#pragma unroll
        for (int r = 0; r < 16; ++r) {
            const float h = hb[r] + a[r] * HinG;
            if (DIR == 0) stu<float>(HF + LRU_UOFF(row0, r), vo_e * 4u, h); else stu<bf16_t>(Y + LRU_UOFF(row0, r), vo_e * 2u, f2bf((hfv[r] + h) * bf2f(gv[r])));
        }
    }
}
__device__ __forceinline__ void lru_phase(const Frame& F) {
    if (F.aff) { for (int k = F.xr; k < 32; k += F.xn) { const int b = F.xx, n = (k >> 3) & 3, sl = k & 7; lru_dir<0>(F, b, n, sl); lru_dir<1>(F, b, n, sl); } }
    else for (int u = F.vcu; u < BATCH * 4 * 8; u += F.G) { const int b = u >> 5, n = (u >> 3) & 3, sl = u & 7; lru_dir<0>(F, b, n, sl); lru_dir<1>(F, b, n, sl); }
#undef LRU_PREFETCH
#undef LRU_ROW0
#undef LRU_UOFF
    __syncthreads();
}
enum { PH_PRO0 = 0, PH_PRO1 = 1, PH_L0 = 2 };
constexpr int N_PHASES = 23;
enum { ST_QKV = 0, ST_ATT, ST_OUT, ST_UP, ST_DOWN, ST_CIN, ST_CONV, ST_LIN, ST_CONV4, ST_SCAN };
__device__ __forceinline__ int stage_of(int l, int s) {
    if (l == 1) return s == 0 ? ST_CIN : s == 1 ? ST_CONV : s == 2 ? ST_OUT : s == 3 ? ST_UP : ST_DOWN;
    if (l == 2) return s == 0 ? ST_LIN : s == 1 ? ST_CONV4 : s == 2 ? ST_SCAN : s == 3 ? ST_OUT : s == 4 ? ST_UP : ST_DOWN;
    return s == 0 ? ST_QKV : s == 1 ? ST_ATT : s == 2 ? ST_OUT : s == 3 ? ST_UP : ST_DOWN;
}
__device__ __forceinline__ int gemm_descs(const Args& A, const Frame& F, int l, int st, pg8::Gemm& g, pg8::Sched& S, pg8::Epi& E) {
    bf16_t* WT = (bf16_t*)(F.ws + OFF_WT); bf16_t* XG = (bf16_t*)(F.ws + OFF_XG); bf16_t* Hb = (bf16_t*)(F.ws + OFF_BIG);
    bf16_t* R1 = (bf16_t*)(F.ws + OFF_R1); bf16_t* R2 = (bf16_t*)(F.ws + OFF_R2);
    bf16_t* Kb = (bf16_t*)(F.ws + OFF_KV); bf16_t* Vb = Kb + (size_t)BATCH * TKV * 256;
    float* SSQ = (float*)(F.ws + OFF_SSQ); const float* MODF = (const float*)(F.ws + OFF_MODF); const float* GAIN = (const float*)(F.ws + OFF_GAIN); const float* SW = (const float*)(F.ws + OFF_SW);
    const bool lat_only = l == 3; const int j = l / 3;
    const bool up = st == ST_UP, down = st == ST_DOWN, outp = st == ST_OUT, qkv = st == ST_QKV, cin = st == ST_CIN, lin = st == ST_LIN;
    const int ek = up ? pg8::EK_MLP1 : (down || outp) ? pg8::EK_RES : qkv ? pg8::EK_QKV : cin ? pg8::EK_GLU : lin ? pg8::EK_LRUIN : 0;
    const size_t wt_off = up ? WT_W1 + (size_t)l * D * DFF : down ? WT_W2 + (size_t)l * D * DFF : outp ? (l == 1 ? WT_COUT : l == 2 ? WT_LOUT : WT_WO + (size_t)j * D * D)
                        : qkv ? WT_QKV + (size_t)j * D * 1536 : cin ? WT_CIN : WT_LIN;
    g.A = down ? Hb : outp ? R2 : XG; g.Bt = WT + wt_off; g.K = down ? DFF : D;
    g.tstepB = (cin ? 128L : 256L) * g.K * 2; g.hstepB = (cin ? 1024L : qkv ? 16L : 128L) * g.K * 2; g.bmap = qkv ? 1 : 0;
    S.nM0 = lat_only ? 64 : 72; S.nN0 = up ? 16 : (down || outp) ? 4 : qkv ? 6 : 8; S.pm00 = 0; S.pn00 = 0;
    const bool two = qkv && lat_only; S.nM1 = two ? 8 : 0; S.nN1 = two ? 2 : 0; S.pm01 = 64; S.pn01 = 4; S.G = F.G; S.c = F.bx;
    S.aff = F.aff; S.xx = F.xx; S.xr = F.xr; S.xn = F.xn; S.nctx = lat_only ? (qkv ? 2 : 0) : S.nN0;
    E.kind = ek; E.ssq = SSQ; E.N = up ? DFF : qkv ? 1536 : 2048;
    E.sw = SW + (up ? SW_MLP + l * 9 * DFF : qkv ? SW_QKV + j * 9 * 1536 : cin ? SW_CIN : SW_LIN);
    E.o0 = up ? Hb : R1; E.o1 = qkv ? Kb : R2; E.o2 = Vb;
    E.xl = F.out; E.xc = (float*)(F.ws + OFF_XC); E.xg = XG; E.ssq_out = SSQ;
    const bool first_res = outp && l == 0;
    E.xrl = first_res ? IN(0) : (const float*)F.out; E.xrc = first_res ? IN(2) : (const float*)(F.ws + OFF_XC);
    E.gate = MODF + (size_t)l * 9 * 6144 + (down ? 5 * D : 2 * D);
    E.bias = (outp && l == 1) ? IN(21) : nullptr;
    E.gain = down ? (l < 3 ? GAIN + (size_t)((l + 1) * 2 + 0) * 9 * D : nullptr) : GAIN + (size_t)(l * 2 + 1) * 9 * D;
    E.qg = IN(11) + j * 64; E.kg = IN(12) + j * 64; E.rope = (const float*)(F.ws + OFF_ROPE);
    return ek;
}

namespace chain {
using namespace pg8;
enum { T_OUT = 0, T_UP = 1, T_DOWN = 2, T_IN = 3 };
constexpr int Q_OFF_WORDS = 16384, C_OFF_WORDS = 32768, MB_POS = 16, MB_RDY = 17, MB_NEXT = 18, END = 1 << 20;
struct Ctx { int l, P, nin, qkv3, x, nlist, pos0, nodeps; unsigned* head; unsigned* cnt; };
__device__ __forceinline__ void decode(const Ctx& c0, int pos, int& type, int& pm, int& pn) {
    int l_ = c0.l; asm volatile("" : "+s"(l_));
    struct { int P, nin, qkv3, x; } c; c.P = l_ == 3 ? 8 : 9; c.qkv3 = l_ == 2; c.nin = l_ == 3 ? 0 : (l_ == 2 ? 6 : 8); c.x = c0.x;
    int j;
    if (c.P == 9) {
        if (pos < 4) { type = T_OUT; j = 8; pn = pos; }
        else if (pos < 36) { type = T_OUT; j = (pos - 4) >> 2; pn = (pos - 4) & 3; }
        else if (pos < 52) { type = T_UP; j = 8; pn = pos - 36; }
        else if (pos < 184) { const int q = pos - 52;
            if (q < 32) { type = T_UP; j = q >> 2; pn = q & 3; }
            else if (q < 36) { type = T_DOWN; j = 8; pn = q - 32; }
            else { const int q2 = q - 36, cg = 1 + (q2 >> 5), r = q2 & 31; type = T_UP; j = r >> 2; pn = 4 * cg + (r & 3); } }
        else if (pos < 216) { type = T_DOWN; j = (pos - 184) >> 2; pn = (pos - 184) & 3; }
        else { int q = pos - 216; const int nin8 = c.qkv3 ? 2 : c.nin; type = T_IN;
            if (q < nin8) { j = 8; pn = c.qkv3 ? 4 + q : q; } else { q -= nin8; j = q / c.nin; pn = q % c.nin; } }
    } else {
        const int nO = 4 * c.P, nU = 16 * c.P, nD = 4 * c.P;
        if (pos < nO) { type = T_OUT; j = pos >> 2; pn = pos & 3; }
        else if (pos < nO + nU) { const int q = pos - nO, cg = q / nO, r = q % nO; type = T_UP; j = r >> 2; pn = 4 * cg + (r & 3); }
        else if (pos < nO + nU + nD) { const int q = pos - nO - nU; type = T_DOWN; j = q >> 2; pn = q & 3; }
        else { const int q = pos - nO - nU - nD; type = T_IN; j = q / c.nin; pn = q % c.nin; }
    }
    pm = j < 8 ? 8 * c.x + j : 64 + c.x;
}
__device__ __forceinline__ unsigned* dep_word(const Ctx& c, int type, int pm, unsigned& need) {
    need = type == T_UP ? 32u : type == T_DOWN ? 128u : type == T_IN ? 32u : 0u;
    if (c.nodeps) need = 0u;
    return c.cnt + ((c.l * 3 + (type > 0 ? type - 1 : 0)) * 72 + pm) * 16;
}
__device__ __forceinline__ int unit_descs(const Args& A, const Frame& F, int l, int type, Gemm& g, Epi& E) {
    Sched S;
    const int le = type == T_IN ? l + 1 : l;
    const int st = type == T_OUT ? ST_OUT : type == T_UP ? ST_UP : type == T_DOWN ? ST_DOWN : (l == 0 ? ST_CIN : l == 1 ? ST_LIN : ST_QKV);
    return gemm_descs(A, F, le, st, g, S, E);
}
struct Stg { const char* A; const char* B; int K; long hB, tB; int bmap; };
__device__ __forceinline__ Stg unit_stage(const Args& A, const Frame& F, int l, int type) {
    Gemm g; Epi E; (void)unit_descs(A, F, l, type, g, E);
    Stg s; s.A = (const char*)g.A; s.B = (const char*)g.Bt; s.K = g.K; s.hB = g.hstepB; s.tB = g.tstepB; s.bmap = g.bmap; return s;
}
__device__ __forceinline__ int stream(const Args& A, const Frame& F, const Ctx& c, LAS unsigned char* lds, volatile LAS unsigned* MISC, const int pos0) {
    const int wid = F.wave, wr = wid >> 2, wc = wid & 3;
    int tid = tid_now(F.wave);
    int lane = tid & 63, fr = lane & 15, fq = lane >> 4;
#define CH_VOFF(vA_, vB_, K_, bm_) do { _Pragma("unroll") for (int _i = 0; _i < 2; ++_i) { int R_, C_; stage_rc(tid * 16 + _i * 8192, R_, C_); \
        const int Rb_ = (bm_) ? qkvmap(R_) : ((R_ & ~31) + perm32(R_ & 31)); vA_[_i] = (unsigned)(R_ * (K_) + C_) * 2u; vB_[_i] = (unsigned)(Rb_ * (K_) + C_) * 2u; } } while (0)
    const unsigned ldsw = (unsigned)wid * 1024u;
    int aoff = lds_byte(wr * 64 + fr, fq * 8), boff = lds_byte(wc * 32 + fr, fq * 8);
    const size_t kstep = (size_t)(BK * 2);
#define PG8_SA(b, h) (((b) * 2 + (h)) * HTB)
#define PG8_SB(b, h) ((4 + (b) * 2 + (h)) * HTB)
#define CH_STAGE_A(bufoff, gbase) do { _Pragma("unroll") for (int _i = 0; _i < 2; ++_i) \
        __builtin_amdgcn_global_load_lds((const unsigned*)((const char*)(gbase) + vA[_i]), (LAS unsigned*)(lds + (bufoff) + ldsw + _i * 8192), 16, 0, 0); } while (0)
#define CH_STAGE_B(bufoff, gbase) do { _Pragma("unroll") for (int _i = 0; _i < 2; ++_i) \
        __builtin_amdgcn_global_load_lds((const unsigned*)((const char*)(gbase) + vB[_i]), (LAS unsigned*)(lds + (bufoff) + ldsw + _i * 8192), 16, 0, 0); } while (0)
#define PG8_LDA(dst, b, h) do { _Pragma("unroll") for (int m = 0; m < 4; ++m) _Pragma("unroll") for (int k = 0; k < 2; ++k) dst[m][k] = *(const LAS bf16x8*)(lds + PG8_SA(b, h) + aoff + m * 2048 + k * 1024); } while (0)
#define PG8_LDB(dst, b, h) do { _Pragma("unroll") for (int n = 0; n < 2; ++n) _Pragma("unroll") for (int k = 0; k < 2; ++k) dst[n][k] = *(const LAS bf16x8*)(lds + PG8_SB(b, h) + boff + n * 2048 + k * 1024); } while (0)
#define PG8_MMA(ai, bj, At, Bt) do { __builtin_amdgcn_s_setprio(1); _Pragma("unroll") for (int m = 0; m < 4; ++m) _Pragma("unroll") for (int n = 0; n < 2; ++n) _Pragma("unroll") for (int k = 0; k < 2; ++k) \
        acc[ai][bj][m][n] = __builtin_amdgcn_mfma_f32_16x16x32_bf16(Bt[n][k], At[m][k], acc[ai][bj][m][n], 0, 0, 0); __builtin_amdgcn_s_setprio(0); } while (0)
#define PG8_WAIT_V(n) asm volatile("s_waitcnt vmcnt(" #n ")" ::: "memory")
#define PG8_WAIT_L(n) asm volatile("s_waitcnt lgkmcnt(" #n ")" ::: "memory")
#define PG8_BAR __builtin_amdgcn_s_barrier()
#define PG8_SCHED __builtin_amdgcn_sched_barrier(0)
    int type, pm, pn; decode(c, pos0, type, pm, pn);
    int Kc; unsigned vA[2], vB[2]; size_t hA, hB; const char* cA; const char* cB;
    { const Stg s0 = unit_stage(A, F, c.l, type); Kc = s0.K; CH_VOFF(vA, vB, Kc, s0.bmap); hA = (size_t)HALF * Kc * 2; hB = (size_t)s0.hB;
      cA = s0.A + (size_t)pm * 2 * hA; cB = s0.B + (size_t)pn * (size_t)s0.tB; }
    f32x4 acc[2][2][4][2];
#pragma unroll
    for (int a = 0; a < 2; ++a)
#pragma unroll
        for (int b = 0; b < 2; ++b)
#pragma unroll
            for (int m = 0; m < 4; ++m)
#pragma unroll
                for (int n = 0; n < 2; ++n) acc[a][b][m][n] = (f32x4){0.f, 0.f, 0.f, 0.f};
    bf16x8 At[4][2], B0[2][2], B1[2][2];
    CH_STAGE_B(PG8_SB(0, 0), cB); CH_STAGE_B(PG8_SB(0, 1), cB + hB); CH_STAGE_A(PG8_SA(0, 0), cA); CH_STAGE_A(PG8_SA(0, 1), cA + hA);
    if (wr == 1) PG8_BAR;
    PG8_WAIT_V(2); PG8_BAR;
    CH_STAGE_B(PG8_SB(1, 0), cB + kstep); CH_STAGE_A(PG8_SA(1, 0), cA + kstep); CH_STAGE_B(PG8_SB(1, 1), cB + hB + kstep);
    PG8_WAIT_V(6); PG8_BAR;
    int ret = END;
    for (;;) {
        const int nt = Kc / BK;
        { asm volatile("" : "+v"(vA[0]), "+v"(vA[1]), "+v"(vB[0]), "+v"(vB[1])); tid = tid_now(F.wave); lane = tid & 63; fr = lane & 15; fq = lane >> 4;
          aoff = lds_byte(wr * 64 + fr, fq * 8); boff = lds_byte(wc * 32 + fr, fq * 8); }
        bool stream_on = false; int npos = END;
        const char* nA = cA; const char* nB = cB; int Kn = Kc; size_t hAn = hA, hBn = hB;
        int ntype = 0, npm = 0, npn = 0;
        unsigned depv = 0u;
        for (int t = 0; t < nt; t += 2) {
            const bool last = (t == nt - 2);
            const char* a1 = cA + (size_t)(t + 1) * kstep;
            const char* a2 = cA + (size_t)(t + 2) * kstep; const char* b2 = cB + (size_t)(t + 2) * kstep;
            if (wid == 0 && (t == nt - 4 || last)) {
                const int np = __builtin_amdgcn_readfirstlane((int)MISC[MB_NEXT]);
                unsigned need = 0u; unsigned* dw = c.cnt;
                if (np < c.nlist) { int ty, p_, q_; decode(c, np, ty, p_, q_); dw = dep_word(c, ty, p_, need); }
                if (!last) { if (need) depv = __hip_atomic_load(dw, __ATOMIC_RELAXED, __HIP_MEMORY_SCOPE_AGENT); }
                else { const unsigned dv = (unsigned)__builtin_amdgcn_readfirstlane((int)depv);
                    if (lane == 0) MISC[MB_RDY] = (dv >= need) ? 1u : 0u;
                    asm volatile("s_waitcnt lgkmcnt(0)" ::: "memory"); }
            }
            if (last) {
                asm volatile("" ::: "memory"); PG8_BAR; asm volatile("" ::: "memory");
                npos = __builtin_amdgcn_readfirstlane((int)MISC[MB_NEXT]); const int rdy = __builtin_amdgcn_readfirstlane((int)MISC[MB_RDY]);
                stream_on = (npos < c.nlist) && rdy != 0;
                if (stream_on && type != T_IN && npos >= 24 * c.P) stream_on = false;
                a2 = cA; b2 = cB;
            }
            PG8_LDB(B0, 0, 0); PG8_LDB(B1, 0, 1); PG8_SCHED; PG8_LDA(At, 0, 0); CH_STAGE_A(PG8_SA(1, 1), a1 + hA);
            if (last && stream_on) {
                decode(c, npos, ntype, npm, npn); const Stg sn = unit_stage(A, F, c.l, ntype);
                Kn = sn.K; CH_VOFF(vA, vB, Kn, sn.bmap); hAn = (size_t)HALF * Kn * 2; hBn = (size_t)sn.hB;
                nA = sn.A + (size_t)npm * 2 * hAn; nB = sn.B + (size_t)npn * (size_t)sn.tB;
                hA = hAn; hB = hBn; a2 = nA; b2 = nB;
            }
            const char* a3 = a2 + kstep; const char* b3 = b2 + kstep;
            PG8_WAIT_V(8); PG8_WAIT_L(0); PG8_BAR; PG8_MMA(0, 0, At, B0); PG8_MMA(0, 1, At, B1); PG8_BAR; PG8_SCHED;
            PG8_LDA(At, 0, 1); CH_STAGE_B(PG8_SB(0, 0), b2); CH_STAGE_B(PG8_SB(0, 1), b2 + hB); CH_STAGE_A(PG8_SA(0, 0), a2);
            PG8_WAIT_V(8); PG8_WAIT_L(0); PG8_BAR; PG8_MMA(1, 0, At, B0); PG8_MMA(1, 1, At, B1); PG8_BAR; PG8_SCHED;
            PG8_LDB(B0, 1, 0); PG8_LDB(B1, 1, 1); PG8_SCHED; PG8_LDA(At, 1, 0); CH_STAGE_A(PG8_SA(0, 1), a2 + hA);
            PG8_WAIT_V(8); PG8_WAIT_L(0); PG8_BAR; PG8_MMA(0, 0, At, B0); PG8_MMA(0, 1, At, B1); PG8_BAR; PG8_SCHED;
            PG8_LDA(At, 1, 1); CH_STAGE_B(PG8_SB(1, 0), b3); CH_STAGE_B(PG8_SB(1, 1), b3 + hB); CH_STAGE_A(PG8_SA(1, 0), a3);
            PG8_WAIT_V(8); PG8_WAIT_L(0); PG8_BAR; PG8_MMA(1, 0, At, B0); PG8_MMA(1, 1, At, B1); PG8_BAR; PG8_SCHED;
        }
        if (wr == 0) PG8_BAR;
        unsigned nposv = 0u;
        if (stream_on && tid_now(F.wave) == 0) nposv = c.pos0 + __hip_atomic_fetch_add(c.head, 1u, __ATOMIC_RELAXED, __HIP_MEMORY_SCOPE_AGENT);
        { const Unit cur{pm, pn}; Gemm g; Epi E; const int ek = unit_descs(A, F, c.l, type, g, E);
          const int ln = tid_now(F.wave) & 63;
          const int fr_ = ln & 15, fq_ = ln >> 4;
          switch (ek) {
          case EK_MLP1: epilogue<EK_MLP1>(lds, E, acc, cur, wr, wc, fr_, fq_); break;
          case EK_RES: epilogue<EK_RES>(lds, E, acc, cur, wr, wc, fr_, fq_); break;
          case EK_GLU: epilogue<EK_GLU>(lds, E, acc, cur, wr, wc, fr_, fq_); break;
          case EK_LRUIN: epilogue<EK_LRUIN>(lds, E, acc, cur, wr, wc, fr_, fq_); break;
          default: epilogue<EK_QKV>(lds, E, acc, cur, wr, wc, fr_, fq_); break;
          } }
        asm volatile("s_waitcnt vmcnt(0)" ::: "memory");
        if (type != T_IN && (tid_now(F.wave) & 63) == 0) (void)__hip_atomic_fetch_add(c.cnt + ((c.l * 3 + type) * 72 + pm) * 16, 1u, __ATOMIC_RELAXED, __HIP_MEMORY_SCOPE_AGENT);
        if (!stream_on) { ret = npos < c.nlist ? npos : END; break; }
        if (tid_now(F.wave) == 0) MISC[MB_NEXT] = nposv;
#pragma unroll
        for (int a = 0; a < 2; ++a)
#pragma unroll
            for (int b = 0; b < 2; ++b)
#pragma unroll
                for (int m = 0; m < 4; ++m)
#pragma unroll
                    for (int n = 0; n < 2; ++n) acc[a][b][m][n] = (f32x4){0.f, 0.f, 0.f, 0.f};
        pm = npm; pn = npn; type = ntype; cA = nA; cB = nB; Kc = Kn;
        if (wr == 1) PG8_BAR;
    }
    PG8_WAIT_V(0);
    PG8_BAR;
#undef PG8_SA
#undef PG8_SB
#undef CH_STAGE_A
#undef CH_STAGE_B
#undef CH_VOFF
#undef PG8_LDA
#undef PG8_LDB
#undef PG8_MMA
#undef PG8_WAIT_V
#undef PG8_WAIT_L
#undef PG8_BAR
#undef PG8_SCHED
    return ret;
}
__device__ __forceinline__ void chain_phase(const Args& A, const Frame& F, int l, volatile LAS unsigned* MISC, int seg = -1) {
    Ctx c; c.l = l; c.P = l == 3 ? 8 : 9; c.nin = l == 3 ? 0 : 8; c.qkv3 = l == 2; c.x = (int)(xb_xcc_id() & 7u);
    if (c.qkv3) c.nin = 6;
    c.nlist = 24 * c.P + (l == 3 ? 0 : c.qkv3 ? 50 : 8 * c.P);
    c.pos0 = 0; c.nodeps = 0;
    if (seg == 1) { c.pos0 = 4 * c.P; c.nlist = 20 * c.P; c.nodeps = 1; }
    unsigned* ctl = (unsigned*)(F.ws + OFF_CTL);
    c.head = ctl + Q_OFF_WORDS + (l * 8 + c.x) * 64; c.cnt = ctl + C_OFF_WORDS;
    int pend = -1; bool in_seen = false;
    for (;;) {
        int pos = pend;
        if (pos < 0) {
            if (tid_now(F.wave) == 0) MISC[MB_POS] = c.pos0 + __hip_atomic_fetch_add(c.head, 1u, __ATOMIC_RELAXED, __HIP_MEMORY_SCOPE_AGENT);
            __syncthreads(); pos = __builtin_amdgcn_readfirstlane((int)MISC[MB_POS]); __syncthreads();
        }
        if (pos >= c.nlist) break;
        { int ty, p_, q_; decode(c, pos, ty, p_, q_); unsigned need; unsigned* dw = dep_word(c, ty, p_, need);
          if (F.wave == 0 && need) { unsigned sp = 0;
              while ((unsigned)__builtin_amdgcn_readfirstlane((int)__hip_atomic_load(dw, __ATOMIC_RELAXED, __HIP_MEMORY_SCOPE_AGENT)) < need) { __builtin_amdgcn_s_sleep(4); if (++sp > (1u << 22)) break; } }
          __syncthreads(); }
        if (pos >= 24 * c.P && !in_seen) { in_seen = true; asm volatile("s_waitcnt vmcnt(0)\n\tbuffer_inv sc0\n\ts_waitcnt vmcnt(0)" ::: "memory"); __syncthreads(); }
        if (tid_now(F.wave) == 0) MISC[MB_NEXT] = c.pos0 + __hip_atomic_fetch_add(c.head, 1u, __ATOMIC_RELAXED, __HIP_MEMORY_SCOPE_AGENT);
        __syncthreads();
        pend = stream(A, F, c, F.lds, MISC, pos);
        if (pend == END) break;
    }
    __syncthreads();
}
}
__global__ void __launch_bounds__(NTHR, 2) mk_fwd(Args A) {
    extern __shared__ __attribute__((aligned(16))) unsigned char lds_raw[];
    Frame F;
    F.lds = (LAS unsigned char*)lds_raw; F.out = A.out; F.ws = A.ws;
    F.tid = threadIdx.x; F.lane = F.tid & 63; F.wave = __builtin_amdgcn_readfirstlane(F.tid >> 6);
    F.G = gridDim.x; { const int bx = blockIdx.x; F.vcu = (F.G % 8 == 0) ? (bx % 8) * (F.G / 8) + bx / 8 : bx; }
    F.aff = 0; F.xx = 0; F.xr = 0; F.xn = 1;
    volatile LAS unsigned* MISC = (volatile LAS unsigned*)(F.lds + LDSCTL_OFF);
    if (threadIdx.x < 16) MISC[threadIdx.x] = 0u;
    __syncthreads();
    XcdBarrier bar = xcd_barrier_post((unsigned*)(GAS unsigned*)(A.ws + OFF_CTL + 16384), MISC + 8);
    const bool chain_req = MK_CHAIN && A.ph_lo == 0 && A.ph_hi == N_PHASES;
    int wv0 = __builtin_amdgcn_readfirstlane((int)threadIdx.x >> 6);
#define FTID() do { const int t_ = tid_now(F.wave); F.tid = t_; F.lane = t_ & 63; } while (0)
#define FRESH() do { int wv_ = wv0; asm volatile("" : "+s"(wv_)); F.wave = wv_; F.tid = 0; F.lane = 0; \
          KArgs ka = (KArgs)__builtin_amdgcn_kernarg_segment_ptr(); asm volatile("" : "+s"(ka)); F.ka = ka; \
          unsigned long long w = (unsigned long long)ka->ws, o = (unsigned long long)ka->out; \
          F.ws = (unsigned char*)(GAS unsigned char*)w; F.out = (float*)(GAS float*)o; \
          int gg = gridDim.x, bx = blockIdx.x; asm volatile("" : "+s"(gg), "+s"(bx)); F.G = gg; F.vcu = (gg % 8 == 0) ? (bx % 8) * (gg / 8) + bx / 8 : bx; F.bx = bx; \
          int af_ = aff_all; asm volatile("" : "+s"(af_)); F.aff = af_; F.xx = (int)(xb_xcc_id() & 7u); int xr_ = xr_all, xn_ = xn_all; asm volatile("" : "+s"(xr_), "+s"(xn_)); F.xr = xr_; F.xn = xn_; } while (0)
    int aff_all = 0, xr_all = 0, xn_all = 1;
    if (A.ph_lo <= PH_PRO0 && PH_PRO0 < A.ph_hi) { FRESH(); FTID(); phase_pro0(A, F); if (PH_PRO0 + 1 < A.ph_hi) xcd_barrier(bar, tid_now(F.wave)); }
    if (A.ph_lo <= PH_PRO1 && PH_PRO1 < A.ph_hi) { FRESH(); FTID(); phase_pro1(A, F); if (PH_PRO1 + 1 < A.ph_hi) xcd_barrier(bar, tid_now(F.wave)); }
    if (MK_AFFINE && chain_req) {
        bool ok = true;
        { unsigned* bw = (unsigned*)(GAS unsigned*)(A.ws + OFF_CTL + 16384);
#pragma unroll
          for (int j = 0; j < 16; ++j) { const unsigned cn = xb_ld(&bw[XB_XCNT(j)]); ok = ok && ((j < 8) ? (cn > 0u) : (cn == 0u)); } }
        aff_all = __builtin_amdgcn_readfirstlane(ok ? 1 : 0);
        xr_all = __builtin_amdgcn_readfirstlane((int)MISC[12]); xn_all = __builtin_amdgcn_readfirstlane((int)MISC[8]); if (xn_all < 1) xn_all = 1;
    }
#define PH_BARRIER() do { if (F.aff) xcd_local_barrier(bar, tid_now(F.wave)); else xcd_barrier(bar, tid_now(F.wave)); } while (0)
    for (int ph = A.ph_lo < PH_L0 ? PH_L0 : A.ph_lo; ph < A.ph_hi; ++ph) {
        FRESH();
        const int q = ph - PH_L0;
        int l, s;
        if (q < 5) { l = 0; s = q; } else if (q < 10) { l = 1; s = q - 5; } else if (q < 16) { l = 2; s = q - 10; } else { l = 3; s = q - 16; }
        const int st = stage_of(l, s);
#ifdef PROBE_UPCHAIN
        if (st == ST_UP && A.ph_lo == 0 && A.ph_hi == N_PHASES) { chain::chain_phase(A, F, l, MISC, 1); if (ph + 1 < A.ph_hi) PH_BARRIER(); continue; }
#endif
        if (chain_req && st == ST_OUT) {
            bool ok = true;
            { unsigned* bw = (unsigned*)(F.ws + OFF_CTL + 16384);
#pragma unroll
              for (int j = 0; j < 16; ++j) { const unsigned cn = xb_ld(&bw[XB_XCNT(j)]); ok = ok && ((j < 8) ? (cn > 0u) : (cn == 0u)); } }
            if (ok) { chain::chain_phase(A, F, l, MISC); ph += (l < 3 ? 3 : 2); if (ph + 1 < A.ph_hi) PH_BARRIER(); continue; }
        }
        pg8::Gemm g{}; pg8::Sched S{}; pg8::Epi E{};
        const int ek = gemm_descs(A, F, l, st, g, S, E);
        switch (ek) {
        case pg8::EK_MLP1: pg8::gemm_phase<pg8::EK_MLP1>(F.lds, tid_now(F.wave), g, S, E); break;
        case pg8::EK_RES: pg8::gemm_phase<pg8::EK_RES>(F.lds, tid_now(F.wave), g, S, E); break;
        case pg8::EK_GLU: pg8::gemm_phase<pg8::EK_GLU>(F.lds, tid_now(F.wave), g, S, E); break;
        case pg8::EK_LRUIN: pg8::gemm_phase<pg8::EK_LRUIN>(F.lds, tid_now(F.wave), g, S, E); break;
        case pg8::EK_QKV: pg8::gemm_phase<pg8::EK_QKV>(F.lds, tid_now(F.wave), g, S, E); break;
        default: break;
        }
#ifdef PROBE_DUP
        if (st == PROBE_DUP) {
            switch (ek) {
            case pg8::EK_MLP1: pg8::gemm_phase<pg8::EK_MLP1>(F.lds, tid_now(F.wave), g, S, E); break;
            case pg8::EK_GLU: pg8::gemm_phase<pg8::EK_GLU>(F.lds, tid_now(F.wave), g, S, E); break;
            case pg8::EK_LRUIN: pg8::gemm_phase<pg8::EK_LRUIN>(F.lds, tid_now(F.wave), g, S, E); break;
            case pg8::EK_QKV: pg8::gemm_phase<pg8::EK_QKV>(F.lds, tid_now(F.wave), g, S, E); break;
            default: break;
            }
            if (st == ST_ATT) { FTID(); attn_phase(F, (char*)lds_raw, l == 3); }
            else if (st == ST_CONV) { FTID(); conv31_phase(A, F); }
            else if (st == ST_CONV4) { FTID(); conv4_phase(A, F); }
            else if (st == ST_SCAN) { FTID(); lru_phase(F); }
            xcd_barrier(bar, tid_now(F.wave));
        }
#endif
        if (st == ST_ATT) { FTID(); attn_phase(F, (char*)lds_raw, l == 3); }
        else if (st == ST_CONV) { FTID(); conv31_phase(A, F); }
        else if (st == ST_CONV4) { FTID(); conv4_phase(A, F); }
        else if (st == ST_SCAN) { FTID(); lru_phase(F); }
        if (ph + 1 < A.ph_hi) PH_BARRIER();
    }
#undef FRESH
#undef FTID
}
__global__ void k_xg(XPtr X, const float* GAINt  , bf16_t* XG, float* SSQ) {
    __shared__ float red[4];
    const int row = blockIdx.x, tid = threadIdx.x, bi = row_bidx(row);
    const float4 v = ((const float4*)X.row(row))[tid];
    const float ss = block_sum256(v.x * v.x + v.y * v.y + v.z * v.z + v.w * v.w, red);
    const float4 g = ((const float4*)(GAINt + (size_t)bi * D))[tid];
    bf16_t* o = XG + (size_t)row * D + tid * 4;
    o[0] = f2bf(v.x * g.x); o[1] = f2bf(v.y * g.y); o[2] = f2bf(v.z * g.z); o[3] = f2bf(v.w * g.w);
    if (tid < 16) SSQ[(size_t)row * 16 + tid] = tid == 0 ? ss : 0.f;
}

template <typename AT, class EPI>
static void gemm(hipStream_t st, const AT* A, int lda, const float* W, int ldw, int Mr, int N, int K, EPI e) {
    hipLaunchKernelGGL((naive_gemm<AT, EPI>), dim3(N / 64, Mr / 64), dim3(256), 0, st, A, lda, W, ldw, K, e);
}
#ifndef MK_CHAIN
#define MK_CHAIN 1
#endif
#ifndef MK_N_LAUNCHES
#define MK_N_LAUNCHES 1
#endif
static int g_grid = 0;
static void fast(hipStream_t st, void* const* d_in, void* d_out, void* d_ws, int lo, int hi) {
    Args a{}; for (int i = 0; i < 29; ++i) a.in[i] = (const float*)d_in[i];
    a.out = (float*)d_out; a.ws = (unsigned char*)d_ws; a.ph_lo = lo; a.ph_hi = hi;
    hipLaunchKernelGGL(mk_fwd, dim3(g_grid), dim3(NTHR), LDS_BYTES, st, a);
}
extern "C" void kernel_launch(void* const* d_in, const int* in_sizes, int n_in, void* d_out, int out_size, void* d_ws, size_t ws_size, hipStream_t stream) {
    if (n_in != 29 || out_size != ML * D || ws_size < WS_END) { fprintf(stderr, "kernel_launch: unexpected shapes (n_in %d out %d ws %zu)\n", n_in, out_size, ws_size); return; }
    if (g_grid == 0) {
        int dev = 0, cus = 0, per_cu = 0;
        if (hipGetDevice(&dev) != hipSuccess || hipDeviceGetAttribute(&cus, hipDeviceAttributeMultiprocessorCount, dev) != hipSuccess) { fprintf(stderr, "kernel_launch: device query failed\n"); g_grid = -1; return; }
        if (hipFuncSetAttribute((const void*)mk_fwd, hipFuncAttributeMaxDynamicSharedMemorySize, LDS_BYTES) != hipSuccess) { fprintf(stderr, "kernel_launch: hipFuncSetAttribute failed\n"); g_grid = -1; return; }
        if (hipOccupancyMaxActiveBlocksPerMultiprocessor(&per_cu, (const void*)mk_fwd, NTHR, LDS_BYTES) != hipSuccess || per_cu < 1) { fprintf(stderr, "kernel_launch: occupancy query says %d blocks per CU\n", per_cu); (void)hipGetLastError(); }
        g_grid = cus;
    }
    if (g_grid < 0) return;
    (void)in_sizes;
    (void)hipMemsetAsync((unsigned char*)d_ws + OFF_CTL, 0, 1 * MiB, stream);
#ifdef PROBE_K
    fast(stream, d_in, d_out, d_ws, 0, PROBE_K);
    (void)hipMemsetAsync((unsigned char*)d_ws + OFF_CTL, 0, 1 * MiB, stream);
#endif
    if (MK_N_LAUNCHES == 1) fast(stream, d_in, d_out, d_ws, 0, N_PHASES);
    else for (int p = 0; p < N_PHASES; ++p) fast(stream, d_in, d_out, d_ws, p, p + 1);
}
```

```cpp
#include <hip/hip_runtime.h>
#include <cstdint>
#include <cstdio>

constexpr int D = 1024, BATCH = 8, SEQ = 2048, CTXL = 256, DEPTH = 4;
constexpr int ML = BATCH * SEQ, MC = BATCH * CTXL, M = ML + MC;
constexpr int NH = 16, NKV = 4, HD = 64, TKV = CTXL + SEQ;
constexpr int DFF = 4096;
constexpr float EPS = 1e-6f;
constexpr float QSCALE = 0.125f * 1.4426950408889634f;

typedef unsigned short bf16_t;
__device__ __forceinline__ float bf2f(bf16_t v) { return __uint_as_float((unsigned)v << 16); }
__device__ __forceinline__ bf16_t f2bf(float f) { unsigned u = __float_as_uint(f); return (bf16_t)((u + 0x7fffu + ((u >> 16) & 1u)) >> 16); }

__device__ __forceinline__ int row_bidx(int r) { return r < ML ? (r >> 11) : 8; }
__device__ __forceinline__ int row_batch(int r) { return r < ML ? (r >> 11) : ((r - ML) >> 8); }
__device__ __forceinline__ int row_tok(int r) { return r < ML ? (r & 2047) : ((r - ML) & 255); }
__device__ __forceinline__ int row_len(int r) { return r < ML ? SEQ : CTXL; }
__device__ __forceinline__ int kv_row(int r) { return row_batch(r) * TKV + (r < ML ? CTXL : 0) + row_tok(r); }

constexpr size_t MiB = 1u << 20;
constexpr size_t OFF_CTL = 0, OFF_MODF = 1 * MiB, OFF_SW = 2 * MiB, OFF_GAIN = 3 * MiB, OFF_TAB = 3 * MiB + 512 * 1024, OFF_SSQ = 4 * MiB;
constexpr size_t OFF_XC = 6 * MiB, OFF_WT = 14 * MiB, OFF_XG = 102 * MiB, OFF_R1 = 138 * MiB, OFF_R2 = 174 * MiB, OFF_BIG = 210 * MiB, OFF_KV = 354 * MiB, WS_END = 372 * MiB;

struct XPtr { float* xl; float* xc; __device__ __forceinline__ float* row(int r) const { return r < ML ? xl + (size_t)r * D : xc + (size_t)(r - ML) * D; } };

__global__ void k_mod(const float* c, const float* c_ctx, const float* mod_w, const float* mod_b, float* MODF) {
    const int idx = blockIdx.x * 256 + threadIdx.x;
    const int n = idx % 6144, bi = (idx / 6144) % 9, l = idx / (6144 * 9);
    const float* cond = bi < 8 ? c + bi * D : c_ctx;
    const float* w = mod_w + (size_t)l * D * 6144 + n;
    float acc = 0.f;
    for (int k = 0; k < D; ++k) { const float x = cond[k]; const float s = x / (1.f + expf(-x)); acc += s * w[(size_t)k * 6144]; }
    MODF[idx] = acc + mod_b[l * 6144 + n];
}
__global__ void k_init(const float* x, const float* ctx, XPtr X) {
    const size_t i = (size_t)blockIdx.x * 256 + threadIdx.x;
    const size_t nl = (size_t)ML * D / 4;
    if (i < nl) ((float4*)X.xl)[i] = ((const float4*)x)[i]; else ((float4*)X.xc)[i - nl] = ((const float4*)ctx)[i - nl];
}
__device__ __forceinline__ float block_sum256(float v, float* red) {
    for (int o = 32; o > 0; o >>= 1) v += __shfl_xor(v, o);
    __syncthreads();
    if ((threadIdx.x & 63) == 0) red[threadIdx.x >> 6] = v;
    __syncthreads();
    return red[0] + red[1] + red[2] + red[3];
}
__global__ void k_normmod(XPtr X, const float* g, const float* MODF_l, int sec, float* HN) {
    __shared__ float red[4];
    const int row = blockIdx.x, tid = threadIdx.x, bi = row_bidx(row);
    const float4 v = ((const float4*)X.row(row))[tid];
    const float ss = block_sum256(v.x * v.x + v.y * v.y + v.z * v.z + v.w * v.w, red);
    const float rstd = rsqrtf(ss * (1.f / D) + EPS);
    const float4 gg = ((const float4*)g)[tid];
    const float4 sh = ((const float4*)(MODF_l + (size_t)bi * 6144 + sec * D))[tid];
    const float4 sc = ((const float4*)(MODF_l + (size_t)bi * 6144 + (sec + 1) * D))[tid];
    float4 o;
    o.x = v.x * rstd * gg.x * (1.f + sc.x) + sh.x; o.y = v.y * rstd * gg.y * (1.f + sc.y) + sh.y;
    o.z = v.z * rstd * gg.z * (1.f + sc.z) + sh.z; o.w = v.w * rstd * gg.w * (1.f + sc.w) + sh.w;
    ((float4*)(HN + (size_t)row * D))[tid] = o;
}

__device__ __forceinline__ float ldA(const float* p) { return *p; }
__device__ __forceinline__ float ldA(const bf16_t* p) { return bf2f(*p); }
template <typename AT, class EPI>
__global__ void __launch_bounds__(256) naive_gemm(const AT* A, int lda, const float* W, int ldw, int K, EPI epi) {
    __shared__ float As[16][68], Bs[16][68];
    const int tid = threadIdx.x, tx = tid & 15, ty = tid >> 4;
    const int m0 = blockIdx.y * 64, n0 = blockIdx.x * 64;
    float acc[4][4] = {};
    for (int k0 = 0; k0 < K; k0 += 16) {
        { const int r = tid >> 2, kk = (tid & 3) * 4; const AT* ap = A + (size_t)(m0 + r) * lda + k0 + kk;
#pragma unroll
          for (int i = 0; i < 4; ++i) As[kk + i][r] = ldA(ap + i); }
        { const int kk = tid >> 4, c = (tid & 15) * 4; const float4 b = *(const float4*)(W + (size_t)(k0 + kk) * ldw + n0 + c);
          Bs[kk][c] = b.x; Bs[kk][c + 1] = b.y; Bs[kk][c + 2] = b.z; Bs[kk][c + 3] = b.w; }
        __syncthreads();
#pragma unroll
        for (int kk = 0; kk < 16; ++kk) {
            float a[4], b[4];
#pragma unroll
            for (int i = 0; i < 4; ++i) { a[i] = As[kk][ty * 4 + i]; b[i] = Bs[kk][tx * 4 + i]; }
#pragma unroll
            for (int i = 0; i < 4; ++i)
#pragma unroll
                for (int j = 0; j < 4; ++j) acc[i][j] += a[i] * b[j];
        }
        __syncthreads();
    }
#pragma unroll
    for (int i = 0; i < 4; ++i)
#pragma unroll
        for (int j = 0; j < 4; ++j) epi(m0 + ty * 4 + i, n0 + tx * 4 + j, acc[i][j]);
}
struct EpiStoreF32 { float* C; int ldc; const float* bias; __device__ __forceinline__ void operator()(int r, int c, float v) const { C[(size_t)r * ldc + c] = v + (bias ? bias[c] : 0.f); } };
struct EpiStoreBf16 { bf16_t* C; int ldc; const float* bias; __device__ __forceinline__ void operator()(int r, int c, float v) const { C[(size_t)r * ldc + c] = f2bf(v + (bias ? bias[c] : 0.f)); } };
struct EpiRelu2 { bf16_t* H; __device__ __forceinline__ void operator()(int r, int c, float v) const { const float t = v > 0.f ? v : 0.f; H[(size_t)r * DFF + c] = f2bf(t * t); } };
struct EpiResid { XPtr X; const float* gate  ; const float* bias;
    __device__ __forceinline__ void operator()(int r, int c, float v) const { float* x = X.row(r) + c; *x += gate[(size_t)row_bidx(r) * 6144 + c] * (v + (bias ? bias[c] : 0.f)); } };

__global__ void k_qkv_post(const float* TMP, const float* qg, const float* kg, bf16_t* Q, bf16_t* Kb, bf16_t* Vb) {
    const int idx = blockIdx.x * 4 + (threadIdx.x >> 6), d = threadIdx.x & 63;
    const int row = idx / 24, s = idx % 24;
    float v = TMP[(size_t)row * 1536 + s * 64 + d];
    if (s < 20) {
        float ss = v * v;
        for (int o = 32; o > 0; o >>= 1) ss += __shfl_xor(ss, o);
        v = v * rsqrtf(ss * (1.f / 64.f) + EPS) * (s < 16 ? qg : kg)[d];
        const float other = __shfl_xor(v, 16);
        if (row < ML) {
            const int t = row_tok(row), a = d >> 5, f = d & 15;
            const float pos = (float)(a == 0 ? (t >> 6) : (t & 63));
            const float inv = powf(10000.f, -(float)f / 16.f), ang = pos * inv, cs = cosf(ang), sn = sinf(ang);
            v = (d & 16) ? (other * sn + v * cs) : (v * cs - other * sn);
        }
    }
    if (s < 16) Q[(size_t)row * D + s * 64 + d] = f2bf(v * QSCALE);
    else (s < 20 ? Kb : Vb)[(size_t)kv_row(row) * 256 + (s & 3) * 64 + d] = f2bf(v);
}
__global__ void __launch_bounds__(256) k_attn_naive(const bf16_t* Q, const bf16_t* Kb, const bf16_t* Vb, bf16_t* O, int nrows) {
    const int idx = blockIdx.x * 256 + threadIdx.x;
    const int h = idx / nrows, row = idx % nrows;
    const int b = row_batch(row), nk = row < ML ? TKV : CTXL, kvh = h >> 2;
    float q[64], o[64];
#pragma unroll
    for (int d = 0; d < 64; ++d) { q[d] = bf2f(Q[(size_t)row * D + h * 64 + d]); o[d] = 0.f; }
    float m = -1e30f, l = 0.f;
    for (int j = 0; j < nk; ++j) {
        const bf16_t* kp = Kb + (size_t)(b * TKV + j) * 256 + kvh * 64;
        const bf16_t* vp = Vb + (size_t)(b * TKV + j) * 256 + kvh * 64;
        float s = 0.f;
#pragma unroll
        for (int d = 0; d < 64; ++d) s += q[d] * bf2f(kp[d]);
        const float mn = fmaxf(m, s), corr = exp2f(m - mn), p = exp2f(s - mn);
        l = l * corr + p; m = mn;
#pragma unroll
        for (int d = 0; d < 64; ++d) o[d] = o[d] * corr + p * bf2f(vp[d]);
    }
    const float il = 1.f / l;
#pragma unroll
    for (int d = 0; d < 64; ++d) O[(size_t)row * D + h * 64 + d] = f2bf(o[d] * il);
}
__global__ void k_glu_post(const float* TMP, bf16_t* U) {
    const size_t i = (size_t)blockIdx.x * 256 + threadIdx.x;
    const size_t row = i / D; const int c = (int)(i % D);
    const float a = TMP[row * 2048 + c], g = TMP[row * 2048 + 1024 + c];
    U[i] = f2bf(a / (1.f + expf(-g)));
}
__global__ void k_conv31_naive(const bf16_t* U, const float* w_dw, const float* b_dw, const float* n_g, const float* n_b, bf16_t* Y) {
    __shared__ float red[4];
    const int row = blockIdx.x, tid = threadIdx.x, c0 = tid * 4;
    const int t = row_tok(row), L = row_len(row), base = row - t;
    float v[4];
#pragma unroll
    for (int i = 0; i < 4; ++i) v[i] = b_dw[c0 + i];
    for (int k = 0; k < 31; ++k) { const int tt = t + k - 15; if (tt < 0 || tt >= L) continue;
        const bf16_t* u = U + (size_t)(base + tt) * D + c0;
#pragma unroll
        for (int i = 0; i < 4; ++i) v[i] += w_dw[k * D + c0 + i] * bf2f(u[i]); }
    const float mean = block_sum256(v[0] + v[1] + v[2] + v[3], red) * (1.f / D);
    float q = 0.f;
#pragma unroll
    for (int i = 0; i < 4; ++i) { v[i] -= mean; q += v[i] * v[i]; }
    const float rstd = rsqrtf(block_sum256(q, red) * (1.f / D) + EPS);
#pragma unroll
    for (int i = 0; i < 4; ++i) { const float y = v[i] * rstd * n_g[c0 + i] + n_b[c0 + i]; Y[(size_t)row * D + c0 + i] = f2bf(y / (1.f + expf(-y))); }
}
__global__ void k_lruin_post(const float* TMP, bf16_t* G, bf16_t* XB) {
    const size_t i = (size_t)blockIdx.x * 256 + threadIdx.x;
    const size_t row = i / D; const int c = (int)(i % D);
    const float x = TMP[row * 2048 + c];
    G[i] = f2bf(0.5f * x * (1.f + tanhf(0.7978845608028654f * (x + 0.044715f * x * x * x))));
    XB[i] = f2bf(TMP[row * 2048 + 1024 + c]);
}
__global__ void k_conv4_naive(const bf16_t* XB, const float* cw  , const float* cb, int dir, bf16_t* U) {
    const size_t i = (size_t)blockIdx.x * 256 + threadIdx.x;
    const int row = (int)(i / D), c = (int)(i % D);
    const int t = row_tok(row), L = row_len(row), base = row - t;
    float v = cb[c];
#pragma unroll
    for (int k = 0; k < 4; ++k) { const int tt = dir == 0 ? t + k - 3 : t + 3 - k; if (tt >= 0 && tt < L) v += cw[k * D + c] * bf2f(XB[(size_t)(base + tt) * D + c]); }
    U[i] = f2bf(v);
}
__global__ void k_scan_naive(const bf16_t* GT, const bf16_t* U, const float* lam  , int dir, bf16_t* HF, const bf16_t* G, bf16_t* Y) {
    const int idx = blockIdx.x * 256 + threadIdx.x, b = idx >> 10, c = idx & 1023;
    const float sp = log1pf(expf(-lam[c]));
    float h = 0.f;
    for (int s = 0; s < TKV; ++s) {
        int row;
        if (s < CTXL) row = ML + b * CTXL + (dir == 0 ? s : CTXL - 1 - s); else row = b * SEQ + (dir == 0 ? s - CTXL : SEQ - 1 - (s - CTXL));
        const size_t o = (size_t)row * D + c;
        const float r = 1.f / (1.f + expf(-bf2f(GT[o]))), ig = 1.f / (1.f + expf(-bf2f(GT[(size_t)M * D + o])));
        const float la = -8.f * r * sp, a = expf(la);
        float mult = sqrtf(-expm1f(2.f * la)); if (s == 0) mult = 1.f;
        h = a * h + mult * ig * bf2f(U[o]);
        if (dir == 0) HF[o] = f2bf(h); else Y[o] = f2bf((bf2f(HF[o]) + h) * bf2f(G[o]));
    }
}

#define LAS __attribute__((address_space(3)))
#define GAS __attribute__((address_space(1)))
typedef short bf16x8 __attribute__((ext_vector_type(8)));
typedef float f32x4 __attribute__((ext_vector_type(4)));
typedef float f32x2 __attribute__((ext_vector_type(2)));
typedef unsigned u32x4 __attribute__((ext_vector_type(4)));
typedef unsigned u32x2 __attribute__((ext_vector_type(2)));
#ifndef MK_AFFINE
#define MK_AFFINE 1
#endif
#ifndef MK_CHAIN
#define MK_CHAIN 1
#endif
constexpr int NWAVES = 8, NTHR = 512;
constexpr int RING_BYTES = 131072, LDSCTL_OFF = 139264, LDS_BYTES = 143360;

constexpr size_t WT_W1 = 0, WT_W2 = WT_W1 + (size_t)4 * D * DFF, WT_QKV = WT_W2 + (size_t)4 * D * DFF, WT_WO = WT_QKV + (size_t)2 * D * 1536,
                 WT_CIN = WT_WO + (size_t)2 * D * D, WT_COUT = WT_CIN + (size_t)D * 2048, WT_LIN = WT_COUT + (size_t)D * D, WT_LOUT = WT_LIN + (size_t)D * 2048, WT_END = WT_LOUT + (size_t)D * D;
static_assert(WT_END * 2 <= 88 * MiB, "weight copies fit their region");
constexpr int SW_MLP = 0, SW_QKV = SW_MLP + 4 * 9 * DFF, SW_CIN = SW_QKV + 2 * 9 * 1536, SW_LIN = SW_CIN + 9 * 2048, SW_END = SW_LIN + 9 * 2048;
static_assert(SW_END * 4 <= (int)MiB, "SW fits");
__device__ __forceinline__ unsigned char* lru_base(unsigned char* ws, int kind  , int b, bool ctx) {
    const size_t pitch = kind == 0 ? 4096 : 2048;
    const size_t sub = kind == 0 ? 0 : (kind == 1 ? 2 : 3);
    if (!ctx) return ws + (OFF_BIG + ((size_t)16 * b) * MiB + sub * 4 * MiB) - (size_t)b * 2048 * pitch;
    return ws + (OFF_BIG + ((size_t)128 + 2 * b) * MiB + sub * (MiB / 2)) - ((size_t)16384 + 256 * (size_t)b) * pitch;
}
constexpr size_t OFF_MODP = OFF_BIG;
constexpr size_t OFF_ROPE = OFF_TAB, OFF_SP = OFF_TAB + 16384;

__device__ __forceinline__ unsigned cvt_pk_bf16(float lo, float hi) { f32x2 v = {lo, hi}; typedef __bf16 bf16x2_t __attribute__((ext_vector_type(2))); bf16x2_t b = __builtin_convertvector(v, bf16x2_t); return __builtin_bit_cast(unsigned, b); }
__device__ __forceinline__ float shx(float v, int mask, int lane) { return __builtin_bit_cast(float, __builtin_amdgcn_ds_bpermute((lane ^ mask) << 2, __builtin_bit_cast(int, v))); }
template <int CTRL> __device__ __forceinline__ float dpp_f(float v) { return __builtin_bit_cast(float, __builtin_amdgcn_update_dpp(0, __builtin_bit_cast(int, v), CTRL, 0xf, 0xf, false)); }
__device__ __forceinline__ float sum_x16_x32(float v) {
    { auto rr = __builtin_amdgcn_permlane16_swap(__float_as_uint(v), __float_as_uint(v), false, false); v = __uint_as_float(rr[0]) + __uint_as_float(rr[1]); }
    { auto rr = __builtin_amdgcn_permlane32_swap(__float_as_uint(v), __float_as_uint(v), false, false); v = __uint_as_float(rr[0]) + __uint_as_float(rr[1]); }
    return v;
}
__device__ __forceinline__ float other_half(float v, int hi) {
    auto rr = __builtin_amdgcn_permlane32_swap(__float_as_uint(v), __float_as_uint(v), false, false); return __uint_as_float(hi ? rr[0] : rr[1]);
}
__device__ __forceinline__ float wave_sum(float v, int lane) {
    (void)lane;
    v += dpp_f<0xB1>(v);
    v += dpp_f<0x4E>(v);
    v += dpp_f<0x141>(v);
    v += dpp_f<0x140>(v);
    return sum_x16_x32(v);
}
__device__ __forceinline__ float fast_sigmoid(float x) { return __builtin_amdgcn_rcpf(1.f + __builtin_amdgcn_exp2f(-1.4426950408889634f * x)); }

#define XB_TMO      128
#define XB_XCNT(j)  (256  + 64 * (j))
#define XB_XSUB(j)  (1280 + 64 * (j))
#define XB_XGEN(j)  (2304 + 64 * (j))
#define XB_TOP      3328
#define XB_TOPGEN   3392
#define XB_LSUB(j)  (3456 + 64 * (j))
#define XB_LGEN(j)  (4480 + 64 * (j))
#define XCD_BAR_WORDS 5504
#define XB_SPIN_CAP (1u << 18)
__device__ __forceinline__ unsigned xb_ld(unsigned* p)              { return __hip_atomic_load(p, __ATOMIC_RELAXED, __HIP_MEMORY_SCOPE_AGENT); }
__device__ __forceinline__ unsigned xb_add(unsigned* p, unsigned v) { return __hip_atomic_fetch_add(p, v, __ATOMIC_RELAXED, __HIP_MEMORY_SCOPE_AGENT); }
__device__ __forceinline__ unsigned xb_xcc_id() { return (unsigned)__builtin_amdgcn_s_getreg((3 << 11) | 20) & 0xFu; }
#define XB_SPIN(cond, bar) do { unsigned _sp = 0; while (cond) { __builtin_amdgcn_s_sleep(1); \
    if ((++_sp & 255u) == 0u) { if (xb_ld(&(bar)[XB_TMO])) break; if (_sp > XB_SPIN_CAP) { atomicAdd(&(bar)[XB_TMO], 1u); break; } } } } while (0)
struct XcdBarrier { unsigned* bar; unsigned x; volatile LAS unsigned* st; };
__device__ __forceinline__ XcdBarrier xcd_barrier_post(unsigned* bar, volatile LAS unsigned* st) {
    XcdBarrier b; b.bar = bar; b.x = xb_xcc_id(); b.st = st;
    if (threadIdx.x == 0) st[4] = xb_add(&bar[XB_XCNT(b.x)], 1u);
    return b;
}
__device__ __forceinline__ void xcd_barrier_complete(unsigned* bar, unsigned x, unsigned& nloc, unsigned& nx) {
    const unsigned G = gridDim.x * gridDim.y * gridDim.z;
    unsigned sum, cnt, mine, sp = 0u;
    for (;;) {
        sum = 0u; cnt = 0u; mine = 0u;
#pragma unroll
        for (unsigned j = 0; j < 16; ++j) { const unsigned c = xb_ld(&bar[XB_XCNT(j)]); sum += c; cnt += (c > 0u) ? 1u : 0u; mine = (j == x) ? c : mine; }
        if (sum == G) break;
        __builtin_amdgcn_s_sleep(1);
        if ((++sp & 255u) == 0u) { if (xb_ld(&bar[XB_TMO])) break; if (sp > XB_SPIN_CAP) { atomicAdd(&bar[XB_TMO], 1u); break; } }
    }
    nloc = mine > 0u ? mine : 1u; nx = cnt > 0u ? cnt : 1u;
}
__device__ __forceinline__ void xcd_barrier(const XcdBarrier& b, const int tid) {
    asm volatile("s_waitcnt vmcnt(0)" ::: "memory");
    __syncthreads();
    if (tid == 0) {
        unsigned* bar; { unsigned long long bp = (unsigned long long)b.bar; asm volatile("" : "+s"(bp)); bar = (unsigned*)(GAS unsigned*)bp; }
        __builtin_amdgcn_s_waitcnt(0);
        unsigned nloc = b.st[0], nx = b.st[1];
        if (nloc == 0u) { xcd_barrier_complete(bar, b.x, nloc, nx); b.st[0] = nloc; b.st[1] = nx; }
        const unsigned old = xb_add(&bar[XB_XSUB(b.x)], 1u);
        const unsigned gen = old / nloc;
        if (old + 1u == (gen + 1u) * nloc) {
            __builtin_amdgcn_fence(__ATOMIC_RELEASE, "agent");
            asm volatile("s_waitcnt vmcnt(0)" ::: "memory");
            const unsigned og = xb_add(&bar[XB_TOP], 1u);
            const unsigned tg = og / nx;
            if (og + 1u == (tg + 1u) * nx) xb_add(&bar[XB_TOPGEN], 1u);
            else XB_SPIN(xb_ld(&bar[XB_TOPGEN]) == tg, bar);
            __builtin_amdgcn_fence(__ATOMIC_ACQUIRE, "agent");
            xb_add(&bar[XB_XGEN(b.x)], 1u);
            asm volatile("s_waitcnt vmcnt(0)" ::: "memory");
        } else {
            XB_SPIN(xb_ld(&bar[XB_XGEN(b.x)]) == gen, bar);
            __builtin_amdgcn_fence(__ATOMIC_ACQUIRE, "agent");
            asm volatile("s_waitcnt vmcnt(0)" ::: "memory");
        }
    }
    __syncthreads();
}

__device__ __forceinline__ void xcd_local_barrier(const XcdBarrier& b, const int tid) {
    asm volatile("s_waitcnt vmcnt(0)" ::: "memory");
    __syncthreads();
    if (tid == 0) {
        unsigned* bar; { unsigned long long bp = (unsigned long long)b.bar; asm volatile("" : "+s"(bp)); bar = (unsigned*)(GAS unsigned*)bp; }
        __builtin_amdgcn_s_waitcnt(0);
        const unsigned nloc = b.st[0];
        const unsigned old = xb_add(&bar[XB_LSUB(b.x)], 1u);
        const unsigned gen = old / nloc;
        if (old + 1u == (gen + 1u) * nloc) xb_add(&bar[XB_LGEN(b.x)], 1u);
        else XB_SPIN(xb_ld(&bar[XB_LGEN(b.x)]) == gen, bar);
        asm volatile("s_waitcnt vmcnt(0)\n\tbuffer_inv sc0\n\ts_waitcnt vmcnt(0)" ::: "memory");
    }
    __syncthreads();
}

template <typename T> __device__ __forceinline__ T ldu(const void* ubase, unsigned voff) { return *(const T*)((const char*)ubase + voff); }
template <typename T> __device__ __forceinline__ void stu(void* ubase, unsigned voff, T v) { *(T*)((char*)ubase + voff) = v; }
template <typename T> __device__ __forceinline__ T ldu_nt(const void* ubase, unsigned voff) { return __builtin_nontemporal_load((const T*)((const char*)ubase + voff)); }
namespace pg8 {
constexpr int BM = 256, BK = 64, HALF = 128, HTB = HALF * BK * 2, NXCD = 8, WGM = 8;
__device__ __forceinline__ int lds_byte(int r, int c) { const int st = (r >> 4) * 2 + (c >> 5), rr = r & 15, cc = c & 31, ob = rr * 64 + cc * 2; return st * 1024 + (ob ^ (((ob >> 9) & 1) << 5)); }
__device__ __forceinline__ void stage_rc(int b, int& R, int& C) { const int st = b / 1024, sb = b % 1024, swz = sb ^ (((sb >> 9) & 1) << 5); R = (st >> 1) * 16 + swz / 64; C = (st & 1) * 32 + (swz % 64) / 2; }
__device__ __forceinline__ int perm32(int rho) { const int n = rho >> 4, i = rho & 15; return 8 * (i >> 2) + 4 * n + (i & 3); }
__device__ __forceinline__ int qkvmap(int R) { const int w = R >> 5, rho = R & 31, n = rho >> 4, i = rho & 15, fq = i >> 2, j = i & 3; return 64 * w + 32 * (fq >> 1) + 8 * (fq & 1) + 4 * n + j; }

struct Unit { int pm, pn; };
struct Sched {
    int nM0, nN0, pm00, pn00, nM1, nN1, pm01, pn01, G, c;
    int aff, xx, xr, xn, nctx;
    __device__ __forceinline__ bool next(int i, Unit& u) const {
        if (aff) { const int L = i * xn + xr, nl = 8 * nN0;
            if (L < nl) { u.pm = 8 * xx + L / nN0; u.pn = L % nN0; return true; }
            if (L < nl + nctx) { u.pm = 64 + xx; u.pn = (nctx == nN0 ? 0 : pn01) + (L - nl); return true; }
            return false; }
        int L = i * G + c; bool s = false;
        const int n0 = nM0 * nN0;
        if (L >= n0) { L -= n0; s = true; if (L >= nM1 * nN1) return false; }
        const int nm = s ? nM1 : nM0, nn = s ? nN1 : nN0, nwg = nm * nn;
        int wgid = L; { const int q = nwg / NXCD, r = nwg % NXCD, xcd = wgid % NXCD, off = wgid / NXCD; wgid = (xcd < r ? xcd * (q + 1) : r * (q + 1) + (xcd - r) * q) + off; }
        const int nig = WGM * nn, gid = wgid / nig, fm = gid * WGM, gsz = (nm - fm) < WGM ? (nm - fm) : WGM;
        u.pm = (s ? pm01 : pm00) + fm + ((wgid % nig) % gsz); u.pn = (s ? pn01 : pn00) + (wgid % nig) / gsz; return true;
    }
};
struct Gemm { const bf16_t* A; const bf16_t* Bt; int K; long tstepB, hstepB; int bmap; };

enum { EK_MLP1 = 1, EK_RES = 2, EK_GLU = 3, EK_LRUIN = 4, EK_QKV = 5, EK_RESO = 6, EK_RESO2 = 7, EK_RES2 = 8 };
struct Epi {
    int kind;
    const float* ssq;
    const float* sw;
    int N;
    bf16_t* o0; bf16_t* o1; bf16_t* o2;
    float* xl; float* xc;
    const float* xrl; const float* xrc;
    const float* gate;
    const float* bias;
    const float* gain;
    bf16_t* xg; float* ssq_out;
    const float* qg; const float* kg; const float* rope;
    bf16_t* xmb; int xmid; bf16_t* xbl; bf16_t* xbc;
};

template <int KIND>
__device__ __forceinline__ void epilogue(LAS unsigned char* lds, const Epi& E, f32x4 (&acc)[2][2][4][2], const Unit& u, int wr, int wc, int fr, int fq) {
    const int bi = u.pm < 64 ? (u.pm >> 3) : 8;
    const int rbase = u.pm * BM + wr * 64 + fr, lane = (fq << 4) | fr;
    float rsall[2][4];
    if constexpr (KIND != EK_RES && KIND != EK_RESO && KIND != EK_RESO2 && KIND != EK_RES2) {
        f32x4 pp[2][4];
#pragma unroll
        for (int ai = 0; ai < 2; ++ai)
#pragma unroll
            for (int m = 0; m < 4; ++m) pp[ai][m] = __builtin_nontemporal_load((const f32x4*)(E.ssq + (size_t)(rbase + ai * HALF + m * 16) * 16 + 4 * fq));
#pragma unroll
        for (int ai = 0; ai < 2; ++ai)
#pragma unroll
            for (int m = 0; m < 4; ++m) { float sq = (pp[ai][m][0] + pp[ai][m][1]) + (pp[ai][m][2] + pp[ai][m][3]); sq = sum_x16_x32(sq); rsall[ai][m] = rsqrtf(sq * (1.f / D) + EPS); }
    }
    if constexpr (KIND == EK_MLP1) {
        const int c0 = u.pn * BM + wc * 32 + 8 * fq;
        f32x4 sw[2][2];
#pragma unroll
        for (int bj = 0; bj < 2; ++bj)
#pragma unroll
            for (int n = 0; n < 2; ++n) sw[bj][n] = *(const f32x4*)(E.sw + (size_t)bi * E.N + c0 + bj * HALF + 4 * n);
#pragma unroll
        for (int ai = 0; ai < 2; ++ai)
#pragma unroll
            for (int m = 0; m < 4; ++m) { const int r = rbase + ai * HALF + m * 16; const float rs = rsall[ai][m];
                bf16_t* rowp = E.o0 + (size_t)r * DFF + c0;
#pragma unroll
                for (int bj = 0; bj < 2; ++bj) { f32x4 v0 = acc[ai][bj][m][0] * rs + sw[bj][0], v1 = acc[ai][bj][m][1] * rs + sw[bj][1];
#pragma unroll
                    for (int j = 0; j < 4; ++j) { const float a = fmaxf(v0[j], 0.f), b = fmaxf(v1[j], 0.f); v0[j] = a * a; v1[j] = b * b; }
                    u32x4 w; w.x = cvt_pk_bf16(v0[0], v0[1]); w.y = cvt_pk_bf16(v0[2], v0[3]); w.z = cvt_pk_bf16(v1[0], v1[1]); w.w = cvt_pk_bf16(v1[2], v1[3]);
                    *(u32x4*)(rowp + bj * HALF) = w; } }
    } else if constexpr (KIND == EK_RES || KIND == EK_RESO || KIND == EK_RESO2 || KIND == EK_RES2) {
        constexpr bool OUTP = KIND == EK_RESO || KIND == EK_RESO2;
        constexpr bool IN_F32 = KIND == EK_RESO, OUT_F32 = KIND == EK_RES;
        const int trow = u.pm * BM + wr * 64 - (u.pm < 64 ? 0 : ML);
        const int cw = u.pn * BM + wc * 32;
        const float* xr_u = (u.pm < 64 ? E.xrl : E.xrc) + (size_t)trow * D + cw;
        float* xw_u = (u.pm < 64 ? E.xl : E.xc) + (size_t)trow * D + cw;
        bf16_t* xg_u = E.xg + (size_t)(u.pm * BM + wr * 64) * D + cw;
        const unsigned vo4 = (unsigned)(fr * D + 8 * fq) * 4u;
        const int wid_ = wr * 4 + wc;
        LAS unsigned char* sx_w = lds + 3 * HTB + wid_ * 1024 + (fr >> 3) * 8192 + (fr & 7) * 128;
        const int pw0 = ((2 * fq) ^ (fr & 7)) * 16, pw1 = ((2 * fq + 1) ^ (fr & 7)) * 16;
        const LAS unsigned char* sx_r = lds + 3 * HTB + wid_ * 1024 + (lane >> 3) * 128 + (((lane & 7) ^ (lane >> 3)) * 16);
        const unsigned vsx = (unsigned)((lane >> 3) * D + (lane & 7) * 4) * 4u;
        LAS unsigned char* sg_w = lds + RING_BYTES + wid_ * 1024 + fr * 64 + ((fq ^ ((fr >> 1) & 3)) * 16);
        const LAS unsigned char* sg_r = lds + RING_BYTES + wid_ * 1024 + (lane >> 2) * 64 + (((lane & 3) ^ ((lane >> 3) & 3)) * 16);
        const unsigned vsg = (unsigned)((lane >> 2) * D + (lane & 3) * 8) * 2u;
        float qs[8];
#pragma unroll
        for (int g8 = 0; g8 < 8; ++g8) qs[g8] = 0.f;
        bf16_t* xm_u = E.xmb + (size_t)(u.pm * BM + wr * 64) * D + cw;
        bf16_t* xb_u = (u.pm < 64 ? E.xbl + (size_t)(u.pm >> 3) * 4194304 + (size_t)((u.pm & 7) * 256 + wr * 64) * D : E.xbc + (size_t)(u.pm - 64) * 524288 + (size_t)(wr * 64) * D) + cw;
        const bf16_t* xin_u = OUTP ? xb_u : xm_u; bf16_t* xout_u = OUTP ? xm_u : xb_u;
        const unsigned vo2 = (unsigned)(fr * D + 8 * fq) * 2u;
        LAS unsigned char* sm_w = lds + 3 * HTB + wid_ * 1024 + fr * 64 + ((fq ^ ((fr >> 1) & 3)) * 16);
        const LAS unsigned char* sm_r = lds + 3 * HTB + wid_ * 1024 + (lane >> 2) * 64 + (((lane & 3) ^ ((lane >> 3) & 3)) * 16);
#define RES_ROW(g8_) (((g8_) >> 2) * HALF + ((g8_) & 3) * 16)
#define RES_TAIL(g8_) do { \
                if constexpr (!OUT_F32) { u32x4 wm; wm.x = cvt_pk_bf16(x0[0], x0[1]); wm.y = cvt_pk_bf16(x0[2], x0[3]); wm.z = cvt_pk_bf16(x1[0], x1[1]); wm.w = cvt_pk_bf16(x1[2], x1[3]); \
                    *(LAS u32x4*)sm_w = wm; { const u32x4 tm = *(const LAS u32x4*)sm_r; stu<u32x4>(xout_u + (size_t)RES_ROW(g8_) * D + bj * HALF, vsg, tm); } } \
                else { float* w_ = xw_u + (size_t)RES_ROW(g8_) * D + bj * HALF; \
                    *(LAS f32x4*)(sx_w + pw0) = x0; *(LAS f32x4*)(sx_w + pw1) = x1; \
                    { const f32x4 t0 = *(const LAS f32x4*)sx_r, t1 = *(const LAS f32x4*)(sx_r + 8192); stu<f32x4>(w_, vsx, t0); stu<f32x4>(w_ + 8 * D, vsx, t1); } } \
                if (E.gain) { \
                    qs[g8_] += (x0[0] * x0[0] + x0[1] * x0[1]) + (x0[2] * x0[2] + x0[3] * x0[3]) + (x1[0] * x1[0] + x1[1] * x1[1]) + (x1[2] * x1[2] + x1[3] * x1[3]); \
                    const f32x4 y0 = x0 * gn0, y1 = x1 * gn1; \
                    u32x4 w; w.x = cvt_pk_bf16(y0[0], y0[1]); w.y = cvt_pk_bf16(y0[2], y0[3]); w.z = cvt_pk_bf16(y1[0], y1[1]); w.w = cvt_pk_bf16(y1[2], y1[3]); \
                    *(LAS u32x4*)sg_w = w; \
                    { const u32x4 tw = *(const LAS u32x4*)sg_r; stu<u32x4>(xg_u + (size_t)RES_ROW(g8_) * D + bj * HALF, vsg, tw); } } } while (0)
#pragma unroll
        for (int bj = 0; bj < 2; ++bj) {
            const int c = cw + bj * HALF + 8 * fq;
            const f32x4 gt0 = *(const f32x4*)(E.gate + (size_t)bi * 6144 + c), gt1 = *(const f32x4*)(E.gate + (size_t)bi * 6144 + c + 4);
            const f32x4 bs0 = E.bias ? *(const f32x4*)(E.bias + c) : (f32x4){0.f, 0.f, 0.f, 0.f}, bs1 = E.bias ? *(const f32x4*)(E.bias + c + 4) : (f32x4){0.f, 0.f, 0.f, 0.f};
            const f32x4 gn0 = E.gain ? *(const f32x4*)(E.gain + (size_t)bi * D + c) : (f32x4){0.f, 0.f, 0.f, 0.f}, gn1 = E.gain ? *(const f32x4*)(E.gain + (size_t)bi * D + c + 4) : (f32x4){0.f, 0.f, 0.f, 0.f};
            if constexpr (!IN_F32) {
                u32x4 xm[8];
#pragma unroll
                for (int g8 = 0; g8 < 8; ++g8) xm[g8] = ldu_nt<u32x4>(xin_u + (size_t)RES_ROW(g8) * D + bj * HALF, vo2);
#pragma unroll
                for (int g8 = 0; g8 < 8; ++g8) { const int ai = g8 >> 2, m = g8 & 3; const u32x4 q = xm[g8];
                    const f32x4 xc0 = {__uint_as_float(q.x << 16), __uint_as_float(q.x & 0xffff0000u), __uint_as_float(q.y << 16), __uint_as_float(q.y & 0xffff0000u)};
                    const f32x4 xc1 = {__uint_as_float(q.z << 16), __uint_as_float(q.z & 0xffff0000u), __uint_as_float(q.w << 16), __uint_as_float(q.w & 0xffff0000u)};
                    const f32x4 x0 = xc0 + gt0 * (acc[ai][bj][m][0] + bs0), x1 = xc1 + gt1 * (acc[ai][bj][m][1] + bs1);
                    RES_TAIL(g8); }
            } else {
                f32x4 xr[4][2];
#pragma unroll
                for (int g8 = 0; g8 < 4; ++g8) { const float* q_ = xr_u + (size_t)RES_ROW(g8) * D + bj * HALF; xr[g8][0] = ldu_nt<f32x4>(q_, vo4); xr[g8][1] = ldu_nt<f32x4>(q_ + 4, vo4); }
#pragma unroll
                for (int g8 = 0; g8 < 8; ++g8) { const int ai = g8 >> 2, m = g8 & 3;
                    const f32x4 xc0 = xr[g8 & 3][0], xc1 = xr[g8 & 3][1];
                    if (g8 < 4) { const float* q_ = xr_u + (size_t)RES_ROW(g8 + 4) * D + bj * HALF; xr[g8 & 3][0] = ldu_nt<f32x4>(q_, vo4); xr[g8 & 3][1] = ldu_nt<f32x4>(q_ + 4, vo4); }
                    const f32x4 x0 = xc0 + gt0 * (acc[ai][bj][m][0] + bs0), x1 = xc1 + gt1 * (acc[ai][bj][m][1] + bs1);
                    RES_TAIL(g8); }
            }
        }
#undef RES_TAIL
        if (E.gain) {
            float* sq_u = E.ssq_out + (size_t)(u.pm * BM + wr * 64) * 16 + 4 * u.pn + wc;
#pragma unroll
            for (int g8 = 0; g8 < 8; ++g8) { float q = sum_x16_x32(qs[g8]);
                if (fq == 0) stu<float>(sq_u + (size_t)RES_ROW(g8) * 16, (unsigned)fr * 64u, q); }
        }
#undef RES_ROW
    } else if constexpr (KIND == EK_GLU) {
        const int c0 = u.pn * HALF + wc * 32 + 8 * fq;
        f32x4 sw[2][2];
#pragma unroll
        for (int bj = 0; bj < 2; ++bj)
#pragma unroll
            for (int n = 0; n < 2; ++n) sw[bj][n] = *(const f32x4*)(E.sw + (size_t)bi * E.N + bj * D + c0 + 4 * n);
#pragma unroll
        for (int ai = 0; ai < 2; ++ai)
#pragma unroll
            for (int m = 0; m < 4; ++m) { const int r = rbase + ai * HALF + m * 16; const float rs = rsall[ai][m];
                f32x4 a0 = acc[ai][0][m][0] * rs + sw[0][0], a1 = acc[ai][0][m][1] * rs + sw[0][1], g0 = acc[ai][1][m][0] * rs + sw[1][0], g1 = acc[ai][1][m][1] * rs + sw[1][1];
#pragma unroll
                for (int j = 0; j < 4; ++j) { a0[j] *= fast_sigmoid(g0[j]); a1[j] *= fast_sigmoid(g1[j]); }
                u32x4 w; w.x = cvt_pk_bf16(a0[0], a0[1]); w.y = cvt_pk_bf16(a0[2], a0[3]); w.z = cvt_pk_bf16(a1[0], a1[1]); w.w = cvt_pk_bf16(a1[2], a1[3]);
                *(u32x4*)(E.o0 + (size_t)r * D + c0) = w; }
    } else if constexpr (KIND == EK_LRUIN) {
        const int c0 = u.pn * BM + wc * 32 + 8 * fq;
        f32x4 sw[2][2];
#pragma unroll
        for (int bj = 0; bj < 2; ++bj)
#pragma unroll
            for (int n = 0; n < 2; ++n) sw[bj][n] = *(const f32x4*)(E.sw + (size_t)bi * E.N + c0 + bj * HALF + 4 * n);
        const bool isg = u.pn < 4;
        bf16_t* ob = isg ? E.o0 + c0 : E.o1 + (c0 - D);
#pragma unroll
        for (int ai = 0; ai < 2; ++ai)
#pragma unroll
            for (int m = 0; m < 4; ++m) { const int r = rbase + ai * HALF + m * 16; const float rs = rsall[ai][m];
#pragma unroll
                for (int bj = 0; bj < 2; ++bj) { f32x4 v0 = acc[ai][bj][m][0] * rs + sw[bj][0], v1 = acc[ai][bj][m][1] * rs + sw[bj][1];
                    if (isg) {
#pragma unroll
                        for (int j = 0; j < 4; ++j) { const float x = v0[j], y = v1[j];
                            v0[j] = x * fast_sigmoid(1.5957691216057308f * (x + 0.044715f * x * x * x)); v1[j] = y * fast_sigmoid(1.5957691216057308f * (y + 0.044715f * y * y * y)); } }
                    u32x4 w; w.x = cvt_pk_bf16(v0[0], v0[1]); w.y = cvt_pk_bf16(v0[2], v0[3]); w.z = cvt_pk_bf16(v1[0], v1[1]); w.w = cvt_pk_bf16(v1[2], v1[3]);
                    *(u32x4*)(ob + (size_t)r * D + bj * HALF) = w; } }
    } else {
        const int a = fq >> 1, f0 = 8 * (fq & 1), d0 = 32 * a + f0;
        const int colh = u.pn * BM + wc * 64;
        f32x4 sw[2][2], gg[2][2];
        const float* gsrc = u.pn < 4 ? E.qg : E.kg;
#pragma unroll
        for (int bj = 0; bj < 2; ++bj)
#pragma unroll
            for (int n = 0; n < 2; ++n) { sw[bj][n] = *(const f32x4*)(E.sw + (size_t)bi * E.N + colh + d0 + 16 * bj + 4 * n); gg[bj][n] = *(const f32x4*)(gsrc + d0 + 16 * bj + 4 * n); }
        const bool lat = u.pm < 64;
        const float osc = u.pn < 4 ? QSCALE : 1.f;
#pragma unroll
        for (int ai = 0; ai < 2; ++ai)
#pragma unroll
            for (int m = 0; m < 4; ++m) { const int r = rbase + ai * HALF + m * 16; const float rs = rsall[ai][m];
                f32x4 x1[2], x2[2];
#pragma unroll
                for (int n = 0; n < 2; ++n) { x1[n] = acc[ai][0][m][n] * rs + sw[0][n]; x2[n] = acc[ai][1][m][n] * rs + sw[1][n]; }
                if (u.pn < 5) {
                    float q = 0.f;
#pragma unroll
                    for (int n = 0; n < 2; ++n)
#pragma unroll
                        for (int j = 0; j < 4; ++j) q += x1[n][j] * x1[n][j] + x2[n][j] * x2[n][j];
                    q = sum_x16_x32(q);
                    const float hr = rsqrtf(q * (1.f / 64.f) + EPS) * osc;
#pragma unroll
                    for (int n = 0; n < 2; ++n) { x1[n] = x1[n] * gg[0][n] * hr; x2[n] = x2[n] * gg[1][n] * hr; }
                    if (lat) {
                        const int t = r & 2047, pos = a == 0 ? (t >> 6) : (t & 63);
#pragma unroll
                        for (int n = 0; n < 2; ++n) { const f32x4 cs = *(const f32x4*)(E.rope + pos * 16 + f0 + 4 * n), sn = *(const f32x4*)(E.rope + 1024 + pos * 16 + f0 + 4 * n);
                            const f32x4 y1 = x1[n] * cs - x2[n] * sn, y2 = x1[n] * sn + x2[n] * cs; x1[n] = y1; x2[n] = y2; }
                    }
                }
                u32x4 w1, w2; w1.x = cvt_pk_bf16(x1[0][0], x1[0][1]); w1.y = cvt_pk_bf16(x1[0][2], x1[0][3]); w1.z = cvt_pk_bf16(x1[1][0], x1[1][1]); w1.w = cvt_pk_bf16(x1[1][2], x1[1][3]);
                w2.x = cvt_pk_bf16(x2[0][0], x2[0][1]); w2.y = cvt_pk_bf16(x2[0][2], x2[0][3]); w2.z = cvt_pk_bf16(x2[1][0], x2[1][1]); w2.w = cvt_pk_bf16(x2[1][2], x2[1][3]);
                bf16_t* op;
                if (u.pn < 4) op = E.o0 + (size_t)r * D + colh + d0;
                else { const int kvr = lat ? (r >> 11) * TKV + CTXL + (r & 2047) : ((r - ML) >> 8) * TKV + ((r - ML) & 255); op = (u.pn == 4 ? E.o1 : E.o2) + (size_t)kvr * 256 + wc * 64 + d0; }
                *(u32x4*)op = w1; *(u32x4*)(op + 16) = w2; }
    }
}

template <int KIND>
__device__ __forceinline__ void gemm_phase(LAS unsigned char* lds, const int tid, const Gemm g, const Sched S, const Epi E) {
    const int wid = __builtin_amdgcn_readfirstlane(tid >> 6), lane = tid & 63, wr = wid >> 2, wc = wid & 3, fr = lane & 15, fq = lane >> 4;
    const int K = g.K, nt = K / BK;
    unsigned voffA[2], voffB[2];
#pragma unroll
    for (int i = 0; i < 2; ++i) { int R, C; stage_rc(tid * 16 + i * 8192, R, C); const int Rb = g.bmap == 0 ? ((R & ~31) + perm32(R & 31)) : qkvmap(R);
        voffA[i] = (unsigned)(R * K + C) * 2u; voffB[i] = (unsigned)(Rb * K + C) * 2u; }
    const size_t kstep = (size_t)(BK * 2);
    const size_t hstepA = (size_t)HALF * K * 2, tstepA = 2 * hstepA;
    const size_t hstepB = (size_t)g.hstepB, tstepB = (size_t)g.tstepB;
    const unsigned ldsw = (unsigned)wid * 1024u;
    const int aoff = lds_byte(wr * 64 + fr, fq * 8), boff = lds_byte(wc * 32 + fr, fq * 8);
#define PG8_SA(b, h) (((b) * 2 + (h)) * HTB)
#define PG8_SB(b, h) ((4 + (b) * 2 + (h)) * HTB)
#define PG8_STAGE(bufoff, gbase, voff) do { _Pragma("unroll") for (int _i = 0; _i < 2; ++_i) \
        __builtin_amdgcn_global_load_lds((const unsigned*)((const char*)(gbase) + (voff)[_i]), (LAS unsigned*)(lds + (bufoff) + ldsw + _i * 8192), 16, 0, 0); } while (0)
#define PG8_LDA(dst, b, h) do { _Pragma("unroll") for (int m = 0; m < 4; ++m) _Pragma("unroll") for (int k = 0; k < 2; ++k) dst[m][k] = *(const LAS bf16x8*)(lds + PG8_SA(b, h) + aoff + m * 2048 + k * 1024); } while (0)
#define PG8_LDB(dst, b, h) do { _Pragma("unroll") for (int n = 0; n < 2; ++n) _Pragma("unroll") for (int k = 0; k < 2; ++k) dst[n][k] = *(const LAS bf16x8*)(lds + PG8_SB(b, h) + boff + n * 2048 + k * 1024); } while (0)
#define PG8_MMA(ai, bj, At, Bt) do { __builtin_amdgcn_s_setprio(1); _Pragma("unroll") for (int m = 0; m < 4; ++m) _Pragma("unroll") for (int n = 0; n < 2; ++n) _Pragma("unroll") for (int k = 0; k < 2; ++k) \
        acc[ai][bj][m][n] = __builtin_amdgcn_mfma_f32_16x16x32_bf16(Bt[n][k], At[m][k], acc[ai][bj][m][n], 0, 0, 0); __builtin_amdgcn_s_setprio(0); } while (0)
#define PG8_WAIT_V(n) asm volatile("s_waitcnt vmcnt(" #n ")" ::: "memory")
#define PG8_WAIT_L(n) asm volatile("s_waitcnt lgkmcnt(" #n ")" ::: "memory")
#define PG8_BAR __builtin_amdgcn_s_barrier()
#define PG8_SCHED __builtin_amdgcn_sched_barrier(0)
    Unit cur, nxt; int ui = 0;
    if (!S.next(0, cur)) return;
    f32x4 acc[2][2][4][2];
#pragma unroll
    for (int a = 0; a < 2; ++a)
#pragma unroll
        for (int b = 0; b < 2; ++b)
#pragma unroll
            for (int m = 0; m < 4; ++m)
#pragma unroll
                for (int n = 0; n < 2; ++n) acc[a][b][m][n] = (f32x4){0.f, 0.f, 0.f, 0.f};
    bf16x8 At[4][2], B0[2][2], B1[2][2];
    const char* cA = (const char*)g.A + (size_t)cur.pm * tstepA; const char* cB = (const char*)g.Bt + (size_t)cur.pn * tstepB;
    PG8_STAGE(PG8_SB(0, 0), cB, voffB); PG8_STAGE(PG8_SB(0, 1), cB + hstepB, voffB); PG8_STAGE(PG8_SA(0, 0), cA, voffA); PG8_STAGE(PG8_SA(0, 1), cA + hstepA, voffA);
    if (wr == 1) PG8_BAR;
    PG8_WAIT_V(2); PG8_BAR;
    PG8_STAGE(PG8_SB(1, 0), cB + kstep, voffB); PG8_STAGE(PG8_SA(1, 0), cA + kstep, voffA); PG8_STAGE(PG8_SB(1, 1), cB + hstepB + kstep, voffB);
    PG8_WAIT_V(6); PG8_BAR;
    for (;;) {
        const bool has_next = S.next(ui + 1, nxt);
        const char* nA = has_next ? (const char*)g.A + (size_t)nxt.pm * tstepA : cA; const char* nB = has_next ? (const char*)g.Bt + (size_t)nxt.pn * tstepB : cB;
        for (int t = 0; t < nt; t += 2) {
            const bool last = (t == nt - 2);
            const char* a1 = cA + (size_t)(t + 1) * kstep;
            const char* a2 = last ? nA : cA + (size_t)(t + 2) * kstep; const char* b2 = last ? nB : cB + (size_t)(t + 2) * kstep;
            const char* a3 = a2 + kstep; const char* b3 = b2 + kstep;
            PG8_LDB(B0, 0, 0); PG8_LDB(B1, 0, 1); PG8_SCHED; PG8_LDA(At, 0, 0); PG8_STAGE(PG8_SA(1, 1), a1 + hstepA, voffA);
            PG8_WAIT_V(8); PG8_WAIT_L(0); PG8_BAR; PG8_MMA(0, 0, At, B0); PG8_MMA(0, 1, At, B1); PG8_BAR; PG8_SCHED;
            PG8_LDA(At, 0, 1); PG8_STAGE(PG8_SB(0, 0), b2, voffB); PG8_STAGE(PG8_SB(0, 1), b2 + hstepB, voffB); PG8_STAGE(PG8_SA(0, 0), a2, voffA);
            PG8_WAIT_V(8); PG8_WAIT_L(0); PG8_BAR; PG8_MMA(1, 0, At, B0); PG8_MMA(1, 1, At, B1); PG8_BAR; PG8_SCHED;
            PG8_LDB(B0, 1, 0); PG8_LDB(B1, 1, 1); PG8_SCHED; PG8_LDA(At, 1, 0); PG8_STAGE(PG8_SA(0, 1), a2 + hstepA, voffA);
            PG8_WAIT_V(8); PG8_WAIT_L(0); PG8_BAR; PG8_MMA(0, 0, At, B0); PG8_MMA(0, 1, At, B1); PG8_BAR; PG8_SCHED;
            PG8_LDA(At, 1, 1); PG8_STAGE(PG8_SB(1, 0), b3, voffB); PG8_STAGE(PG8_SB(1, 1), b3 + hstepB, voffB); PG8_STAGE(PG8_SA(1, 0), a3, voffA);
            PG8_WAIT_V(8); PG8_WAIT_L(0); PG8_BAR; PG8_MMA(1, 0, At, B0); PG8_MMA(1, 1, At, B1); PG8_BAR; PG8_SCHED;
        }
        if (wr == 0) PG8_BAR;
        epilogue<KIND>(lds, E, acc, cur, wr, wc, fr, fq);
        if (!has_next) break;
#pragma unroll
        for (int a = 0; a < 2; ++a)
#pragma unroll
            for (int b = 0; b < 2; ++b)
#pragma unroll
                for (int m = 0; m < 4; ++m)
#pragma unroll
                    for (int n = 0; n < 2; ++n) acc[a][b][m][n] = (f32x4){0.f, 0.f, 0.f, 0.f};
        cur = nxt; cA = nA; cB = nB; ++ui;
        if (wr == 1) PG8_BAR;
    }
    PG8_WAIT_V(0);
    PG8_BAR;
#undef PG8_SA
#undef PG8_SB
#undef PG8_STAGE
#undef PG8_LDA
#undef PG8_LDB
#undef PG8_MMA
#undef PG8_WAIT_V
#undef PG8_WAIT_L
#undef PG8_BAR
#undef PG8_SCHED
}
}


namespace attn_body {
using bf16=unsigned short;
using bf16x8=__attribute__((ext_vector_type(8)))short;
using s16x4=__attribute__((ext_vector_type(4)))short;
using f32x16=__attribute__((ext_vector_type(16)))float;
using u32x4=__attribute__((ext_vector_type(4)))unsigned;
constexpr int D=64,QP=1024,KP=256;
constexpr int NW=8,QBLK=32,QB=QBLK*NW,KVBLK=64;
__device__ __forceinline__ int crow(int r,int hi){return (r&3)+8*(r>>2)+4*hi;}
#define SBAR() __builtin_amdgcn_sched_barrier(0)
constexpr int NSLOT=3, SLOTB=8192;
constexpr int LDS_K=0, LDS_V=NSLOT*SLOTB, LDS_WS=2*NSLOT*SLOTB, LDS_OST=LDS_WS+NW*64*4, LDS_BYTES=LDS_OST+NW*4096;
constexpr float C2=0.125f*1.4426950408889634f;
__device__ __forceinline__ void glds16(const void*gsrc,unsigned lds_dst){unsigned keep;
  asm volatile("s_mov_b32 %0, m0\n\ts_mov_b32 m0, %2\n\ts_nop 0\n\tglobal_load_lds_dwordx4 %1, off\n\ts_mov_b32 m0, %0":"=&s"(keep):"v"(gsrc),"s"(lds_dst):"memory");}
__device__ __forceinline__ float max3f(float a,float b,float c){float r;asm("v_max3_f32 %0, %1, %2, %3":"=v"(r):"v"(a),"v"(b),"v"(c));return r;}
__device__ __forceinline__ float max2f(float a,float b){float r;asm("v_max_f32_e32 %0, %1, %2":"=v"(r):"v"(a),"v"(b));return r;}
__device__ __forceinline__ float fadd_s(float a,float b){float r;asm("v_add_f32_e32 %0, %1, %2":"=v"(r):"v"(a),"v"(b));return r;}
__device__ __forceinline__ float fsub_s(float a,float b){float r;asm("v_sub_f32_e32 %0, %1, %2":"=v"(r):"v"(a),"v"(b));return r;}
typedef float f32x2_t __attribute__((ext_vector_type(2))); typedef __bf16 bf16x2_t __attribute__((ext_vector_type(2)));
__device__ __forceinline__ unsigned cvtpk_s(float lo,float hi){f32x2_t v={lo,hi};bf16x2_t b=__builtin_convertvector(v,bf16x2_t);return __builtin_bit_cast(unsigned,b);}
#define WAIT_BAR(N) asm volatile("s_waitcnt vmcnt(" #N ") lgkmcnt(0)\n\ts_barrier":::"memory")

__device__ __forceinline__ void qkt(f32x16&p0,f32x16&p1,const char*Kslot,const bf16x8*qr,const f32x16&negm,int r32,int hi){
  const char*kb=Kslot+hi*1024+r32*16;
  #pragma unroll
  for(int d0=0;d0<4;++d0){
    const bf16x8 b0=*reinterpret_cast<const bf16x8*>(kb+d0*2048);
    const bf16x8 b1=*reinterpret_cast<const bf16x8*>(kb+d0*2048+512);
    if(d0==0){p0=__builtin_amdgcn_mfma_f32_32x32x16_bf16(b0,qr[0],negm,0,0,0);p1=__builtin_amdgcn_mfma_f32_32x32x16_bf16(b1,qr[0],negm,0,0,0);}
    else{p0=__builtin_amdgcn_mfma_f32_32x32x16_bf16(b0,qr[d0],p0,0,0,0);p1=__builtin_amdgcn_mfma_f32_32x32x16_bf16(b1,qr[d0],p1,0,0,0);}}
}
typedef __attribute__((address_space(3))) const char* lds_cptr;
typedef short v4i16_t __attribute__((ext_vector_type(4)));
__device__ __forceinline__ void kload8(bf16x8*kf,lds_cptr kp){
  kf[0]=*(const __attribute__((address_space(3))) bf16x8*)(kp);      kf[1]=*(const __attribute__((address_space(3))) bf16x8*)(kp+512);
  kf[2]=*(const __attribute__((address_space(3))) bf16x8*)(kp+2048); kf[3]=*(const __attribute__((address_space(3))) bf16x8*)(kp+2560);
  kf[4]=*(const __attribute__((address_space(3))) bf16x8*)(kp+4096); kf[5]=*(const __attribute__((address_space(3))) bf16x8*)(kp+4608);
  kf[6]=*(const __attribute__((address_space(3))) bf16x8*)(kp+6144); kf[7]=*(const __attribute__((address_space(3))) bf16x8*)(kp+6656);
}
__device__ __forceinline__ void kload2(bf16x8*kf,lds_cptr kp,int j){ kf[2*j]=*(const __attribute__((address_space(3))) bf16x8*)(kp+j*2048); kf[2*j+1]=*(const __attribute__((address_space(3))) bf16x8*)(kp+j*2048+512); }
__device__ __forceinline__ s16x4 vtr(lds_cptr p){ return __builtin_bit_cast(s16x4,__builtin_amdgcn_ds_read_tr16_b64_v4i16((__attribute__((address_space(3))) v4i16_t*)p)); }
__device__ __forceinline__ float rowmax(const f32x16&p0,const f32x16&p1){
  float a=max3f(p0[0],p0[1],p1[0]),b=max3f(p0[2],p0[3],p1[1]);a=max3f(a,p1[2],p1[3]);
  #pragma unroll
  for(int r=4;r<16;r+=4){a=max3f(a,p0[r],p0[r+1]);b=max3f(b,p0[r+2],p0[r+3]);a=max3f(a,p1[r],p1[r+1]);b=max3f(b,p1[r+2],p1[r+3]);}
  const float m=max2f(a,b);
  auto rr=__builtin_amdgcn_permlane32_swap(__float_as_uint(m),__float_as_uint(m),false,false);
  return max2f(__uint_as_float(rr[0]),__uint_as_float(rr[1]));
}
__device__ __forceinline__ void pv(f32x16*o,int vb,bf16x8 pa0,bf16x8 pa1,bf16x8 pa2,bf16x8 pa3){
  #pragma unroll
  for(int d0=0;d0<2;++d0){s16x4 lo[4],hi[4];
    #pragma unroll
    for(int ks=0;ks<4;++ks){
      asm volatile("ds_read_b64_tr_b16 %0,%1 offset:%c2":"=&v"(lo[ks]):"v"(vb),"i"(d0*4096+ks*1024):"memory");
      asm volatile("ds_read_b64_tr_b16 %0,%1 offset:%c2":"=&v"(hi[ks]):"v"(vb),"i"(d0*4096+ks*1024+512):"memory");}
    asm volatile("s_waitcnt lgkmcnt(0)":::"memory");SBAR();
    #define PK(k) (bf16x8){lo[k][0],lo[k][1],lo[k][2],lo[k][3],hi[k][0],hi[k][1],hi[k][2],hi[k][3]}
    o[d0]=__builtin_amdgcn_mfma_f32_32x32x16_bf16(pa0,PK(0),o[d0],0,0,0);
    o[d0]=__builtin_amdgcn_mfma_f32_32x32x16_bf16(pa1,PK(1),o[d0],0,0,0);
    o[d0]=__builtin_amdgcn_mfma_f32_32x32x16_bf16(pa2,PK(2),o[d0],0,0,0);
    o[d0]=__builtin_amdgcn_mfma_f32_32x32x16_bf16(pa3,PK(3),o[d0],0,0,0);
    #undef PK
  }
}

#ifndef ATTN_STORE16
#define ATTN_STORE16(p,v) (*(u32x4*)(p)=(v))
#endif
template<int THRL,bool NOMAX> __device__ __forceinline__ void attn_unit(const int tid,long qrow0,int h,long kvrow0,const int NT,const bf16*Q,const bf16*__restrict__ K,const bf16*__restrict__ V,bf16*O,char*shm){
  const int lane=tid&63,r32=lane&31,hi=lane>>5; const int wid=__builtin_amdgcn_readfirstlane(tid>>6);
  const bf16*Qw=Q+(qrow0+wid*QBLK)*QP+h*D;
  const bf16*Kh=K+kvrow0*KP+(h>>2)*D,*Vh=V+kvrow0*KP+(h>>2)*D;
  const unsigned lds0=(unsigned)(uintptr_t)shm;
  float*wsf=(float*)(shm+LDS_WS)+wid*64;
  const bf16*ksrc=Kh+(long)lane*KP+wid*8;
  const bf16*vsrc=Vh+(long)(16*(wid&3)+(lane>>2))*KP+(wid>>2)*32+(lane&3)*8;
  const unsigned kdst=lds0+LDS_K+wid*1024, vdst=lds0+LDS_V+wid*1024;
  #define DMA_K(t,slot) glds16(ksrc+(long)(t)*KVBLK*KP,(unsigned)__builtin_amdgcn_readfirstlane(kdst+(slot)))
  #define DMA_V(t,slot) glds16(vsrc+(long)(t)*KVBLK*KP,(unsigned)__builtin_amdgcn_readfirstlane(vdst+(slot)))
  const int vb0=(int)(lds0+LDS_V)+((lane>>4)&1)*32+(lane&3)*8+(4*hi+((lane&15)>>2))*64;
  const char*Kbase=shm+LDS_K; bf16x8 kf[8];
  const lds_cptr shm3=(lds_cptr)shm; const lds_cptr kp0=shm3+LDS_K+hi*1024+r32*16; const lds_cptr vp0=shm3+LDS_V+((lane>>4)&1)*32+(lane&3)*8+(4*hi+((lane&15)>>2))*64;
  DMA_K(0,0);DMA_V(0,0);DMA_K(1,SLOTB);
  bf16x8 qr[4];
  #pragma unroll
  for(int d0=0;d0<4;++d0)qr[d0]=*reinterpret_cast<const bf16x8*>(&Qw[(long)r32*QP+d0*16+hi*8]);
  float mhat=0.f,l_reg=0.f;f32x16 o[2];o[0]=f32x16{};o[1]=f32x16{};const f32x16 negm=f32x16{};
  #define CMASK(P0,P1,t) do{}while(0)
  bool resc=false;
  #define START(P0,P1) do{ if constexpr(!NOMAX){ const float rm=rowmax(P0,P1); resc=false; \
    { const float dl=rm; mhat=fadd_s(mhat,dl); \
      _Pragma("unroll") for(int r=0;r<16;++r){P0[r]=fsub_s(P0[r],dl);P1[r]=fsub_s(P1[r],dl);} \
      } } \
    _Pragma("unroll") for(int r=0;r<16;++r)P0[r]=__builtin_amdgcn_exp2f(P0[r]); }while(0)
  #define RESC() do{ if constexpr(!NOMAX){ if(resc){ asm volatile("s_waitcnt lgkmcnt(0)":::"memory"); \
      _Pragma("unroll") for(int d_=0;d_<2;++d_) _Pragma("unroll") for(int r=0;r<16;++r)o[d_][r]*=wsf[crow(r,hi)]; } } }while(0)
  f32x16 pA0,pA1,pB0,pB1;
  int sl_prev=0,sl_cur=0,sl_next=SLOTB;
  #define ROT() do{sl_prev=sl_cur;sl_cur=sl_next;sl_next=(sl_next==(NSLOT-1)*SLOTB)?0:sl_next+SLOTB;}while(0)
  DMA_K(2,2*SLOTB);
  WAIT_BAR(3);
  qkt(pA0,pA1,Kbase,qr,negm,r32,hi);asm volatile("s_nop 15\n\ts_nop 7":"+v"(pA0),"+v"(pA1));CMASK(pA0,pA1,0);
  START(pA0,pA1);
  _Pragma("unroll") for(int r=0;r<16;++r)pA1[r]=__builtin_amdgcn_exp2f(pA1[r]);
  WAIT_BAR(0);
  DMA_K(3,0);DMA_V(1,SLOTB);
  ROT();
  kload8(kf,kp0+sl_cur);
  WAIT_BAR(2);
  s16x4 vlo[8],vhi[8]; u32x4 pw0,pw1,pw2,pw3;
  #define PKW(P,B) cvtpk_s(P[B],P[B+1])
  #define PAF(k) __builtin_bit_cast(bf16x8,pw##k)
  #define VFR(i) (bf16x8){vlo[i][0],vlo[i][1],vlo[i][2],vlo[i][3],vhi[i][0],vhi[i][1],vhi[i][2],vhi[i][3]}
  #define PIN(x) asm volatile("":"+v"(x))
  #define MX3(a,b,c) __builtin_fmaxf(__builtin_fmaxf((a),(b)),(c))
  #define GAPA(MF,A0,A1,A2,A3,W0,W1,PW) do{ MF; sacc+=A0; sacc+=A1; sacc+=A2; sacc+=A3; PIN(sacc); W0; W1; PIN(PW); SBAR(); }while(0)
  #define EX(v) __builtin_amdgcn_exp2f(v)
  #define GAPB(MF,X,B) do{ MF; X[B]=EX(X[B]); X[B+1]=EX(X[B+1]); X[B+2]=EX(X[B+2]); X[B+3]=EX(X[B+3]); PIN(X); SBAR(); }while(0)
  #define VRD(i) do{ vlo[i]=vtr(vp_+(((i)>>2)*4096+((i)&3)*1024)); vhi[i]=vtr(vp_+(((i)>>2)*4096+((i)&3)*1024+512)); }while(0)
  #define KRD(G,j) do{ if(G){ kload2(kf,kp0+sl_next,j); SBAR(); } }while(0)
  #define STEP(C0,C1,P0,P1,t,GK,GV,GL) do{ SBAR(); \
    const lds_cptr vp_=vp0+sl_prev; \
    VRD(0); SBAR(); float sacc=(P0[0]+P0[1]); \
    GAPA(C0=__builtin_amdgcn_mfma_f32_32x32x16_bf16(kf[0],qr[0],negm,0,0,0), P0[2],P0[3],P0[4],P0[5],     pw0[0]=PKW(P0,0), pw0[1]=PKW(P0,2), pw0); \
    VRD(4); SBAR(); GAPA(C1=__builtin_amdgcn_mfma_f32_32x32x16_bf16(kf[1],qr[0],negm,0,0,0), P0[6],P0[7],P0[8],P0[9],     pw0[2]=PKW(P0,4), pw0[3]=PKW(P0,6), pw0); \
    VRD(1); SBAR(); GAPA(C0=__builtin_amdgcn_mfma_f32_32x32x16_bf16(kf[2],qr[1],C0,0,0,0),   P0[10],P0[11],P0[12],P0[13], pw1[0]=PKW(P0,8), pw1[1]=PKW(P0,10), pw1); \
    VRD(5); SBAR(); GAPA(C1=__builtin_amdgcn_mfma_f32_32x32x16_bf16(kf[3],qr[1],C1,0,0,0),   P0[14],P0[15],P1[0],P1[1],   pw1[2]=PKW(P0,12),pw1[3]=PKW(P0,14), pw1); \
    VRD(2); SBAR(); GAPA(C0=__builtin_amdgcn_mfma_f32_32x32x16_bf16(kf[4],qr[2],C0,0,0,0),   P1[2],P1[3],P1[4],P1[5],     pw2[0]=PKW(P1,0), pw2[1]=PKW(P1,2), pw2); \
    VRD(6); SBAR(); GAPA(C1=__builtin_amdgcn_mfma_f32_32x32x16_bf16(kf[5],qr[2],C1,0,0,0),   P1[6],P1[7],P1[8],P1[9],     pw2[2]=PKW(P1,4), pw2[3]=PKW(P1,6), pw2); \
    VRD(3); SBAR(); GAPA(C0=__builtin_amdgcn_mfma_f32_32x32x16_bf16(kf[6],qr[3],C0,0,0,0),   P1[10],P1[11],P1[12],P1[13], pw3[0]=PKW(P1,8), pw3[1]=PKW(P1,10), pw3); \
    VRD(7); SBAR(); GAPA(C1=__builtin_amdgcn_mfma_f32_32x32x16_bf16(kf[7],qr[3],C1,0,0,0),   P1[14],P1[15],0.f,0.f,       pw3[2]=PKW(P1,12),pw3[3]=PKW(P1,14), pw3); \
    l_reg+=sacc; \
    if(GK){DMA_K((t)+3,sl_cur);} if(GV){DMA_V((t)+1,sl_next);} \
    CMASK(C0,C1,t); \
    if constexpr(!NOMAX){ _Pragma("unroll") for(int r=0;r<16;++r){C0[r]-=mhat;C1[r]-=mhat;} \
    { float a=MX3(C0[0],C0[1],C1[0]),b=MX3(C0[2],C0[3],C1[1]); a=MX3(a,C1[2],C1[3]); \
      _Pragma("unroll") for(int r=4;r<16;r+=4){a=MX3(a,C0[r],C0[r+1]);b=MX3(b,C0[r+2],C0[r+3]);a=MX3(a,C1[r],C1[r+1]);b=MX3(b,C1[r+2],C1[r+3]);} \
      float rm=__builtin_fmaxf(a,b); { auto rr=__builtin_amdgcn_permlane32_swap(__float_as_uint(rm),__float_as_uint(rm),false,false); rm=__builtin_fmaxf(__uint_as_float(rr[0]),__uint_as_float(rr[1])); } \
      resc=false; \
      if(__builtin_expect(__any(rm>(float)THRL),0)){ const float dl=__builtin_fmaxf(rm,0.f); mhat+=dl; \
        _Pragma("unroll") for(int r=0;r<16;++r){C0[r]-=dl;C1[r]-=dl;} \
        const float f=__builtin_amdgcn_exp2f(-dl); l_reg*=f; if(hi==0)wsf[r32]=f; resc=true; } } } \
    SBAR(); \
    GAPB(o[0]=__builtin_amdgcn_mfma_f32_32x32x16_bf16(PAF(0),VFR(0),o[0],0,0,0), C0,0); \
    GAPB(o[1]=__builtin_amdgcn_mfma_f32_32x32x16_bf16(PAF(0),VFR(4),o[1],0,0,0), C0,4); \
    KRD(GL,0); GAPB(o[0]=__builtin_amdgcn_mfma_f32_32x32x16_bf16(PAF(1),VFR(1),o[0],0,0,0), C0,8); \
    KRD(GL,1); GAPB(o[1]=__builtin_amdgcn_mfma_f32_32x32x16_bf16(PAF(1),VFR(5),o[1],0,0,0), C0,12); \
    KRD(GL,2); GAPB(o[0]=__builtin_amdgcn_mfma_f32_32x32x16_bf16(PAF(2),VFR(2),o[0],0,0,0), C1,0); \
    KRD(GL,3); GAPB(o[1]=__builtin_amdgcn_mfma_f32_32x32x16_bf16(PAF(2),VFR(6),o[1],0,0,0), C1,4); \
    GAPB(o[0]=__builtin_amdgcn_mfma_f32_32x32x16_bf16(PAF(3),VFR(3),o[0],0,0,0), C1,8); \
    GAPB(o[1]=__builtin_amdgcn_mfma_f32_32x32x16_bf16(PAF(3),VFR(7),o[1],0,0,0), C1,12); \
    }while(0)
  int t=1;
  for(;t+5<NT;t+=2){
    STEP(pB0,pB1,pA0,pA1,t,true,true,true);     WAIT_BAR(2); RESC(); ROT();
    STEP(pA0,pA1,pB0,pB1,t+1,true,true,true);   WAIT_BAR(2); RESC(); ROT();
  }
  #undef CMASK
  #define CMASK(P0,P1,t) do{}while(0)
  #define ENDW(tt) do{ if((tt)+3<NT){WAIT_BAR(2);} else if((tt)+2<NT){WAIT_BAR(1);} else {WAIT_BAR(0);} }while(0)
  for(;t+1<NT;t+=2){
    STEP(pB0,pB1,pA0,pA1,t,(t+3<NT),(t+1<NT),(t+1<NT));       ENDW(t);   RESC(); ROT();
    STEP(pA0,pA1,pB0,pB1,t+1,(t+4<NT),(t+2<NT),(t+2<NT));     ENDW(t+1); RESC(); ROT();
  }
  STEP(pB0,pB1,pA0,pA1,NT-1,false,false,false); RESC();
  { float sacc=pB0[0]+pB0[1]; _Pragma("unroll") for(int r=2;r<16;++r)sacc+=pB0[r]; _Pragma("unroll") for(int r=0;r<16;++r)sacc+=pB1[r]; l_reg+=sacc;
    pw0=(u32x4){PKW(pB0,0),PKW(pB0,2),PKW(pB0,4),PKW(pB0,6)};pw1=(u32x4){PKW(pB0,8),PKW(pB0,10),PKW(pB0,12),PKW(pB0,14)};pw2=(u32x4){PKW(pB1,0),PKW(pB1,2),PKW(pB1,4),PKW(pB1,6)};pw3=(u32x4){PKW(pB1,8),PKW(pB1,10),PKW(pB1,12),PKW(pB1,14)};
    SBAR(); pv(o,vb0+sl_cur,PAF(0),PAF(1),PAF(2),PAF(3)); }
  #undef PKW
  #undef PAF
  #undef VFR
  #undef PIN
  #undef MX3
  #undef GAPA
  #undef GAPB
  #undef EX
  #undef VRD
  #undef KRD
  #undef STEP
  #undef ENDW
  {auto rr=__builtin_amdgcn_permlane32_swap(__float_as_uint(l_reg),__float_as_uint(l_reg),false,false);l_reg=__uint_as_float(rr[0])+__uint_as_float(rr[1]);}
  if(hi==0)wsf[32+r32]=l_reg;asm volatile("s_waitcnt lgkmcnt(0)":::"memory");
  float rli[16];
  #pragma unroll
  for(int r=0;r<16;++r)rli[r]=__builtin_amdgcn_rcpf(wsf[32+crow(r,hi)]);
  bf16*Ow=O+(qrow0+wid*QBLK)*QP+h*D;
  { bf16*stg=(bf16*)(shm+LDS_OST)+wid*2048;
    #pragma unroll
    for(int r=0;r<16;++r){const int orow=crow(r,hi);
      #pragma unroll
      for(int d0=0;d0<2;++d0)stg[orow*64+d0*32+r32]=f2bf(o[d0][r]*rli[r]);}
    asm volatile("s_waitcnt lgkmcnt(0)":::"memory");
    #pragma unroll
    for(int i=0;i<4;++i){const int row=i*8+(lane>>3),ch=lane&7; const u32x4 v=*(const u32x4*)(stg+row*64+ch*8); ATTN_STORE16(Ow+(long)row*QP+ch*8,v);} }
  asm volatile("s_waitcnt lgkmcnt(0)\n\ts_barrier":::"memory");
  #undef DMA_K
  #undef DMA_V
  #undef CMASK
  #undef START
  #undef RESC
  #undef ROT
}
constexpr int ATTN_LDS_BYTES=LDS_BYTES;
#undef SBAR
#undef WAIT_BAR
}

struct Args { const float* in[29]; float* out; unsigned char* ws; int ph_lo, ph_hi; };
typedef const __attribute__((address_space(4))) struct Args* KArgs;
struct Frame {
    LAS unsigned char* lds; float* out; unsigned char* ws; KArgs ka;
    int tid, lane, wave, vcu, G, bx;
    int aff, xx, xr, xn;
};
#define IN(k) ((const float*)(GAS const float*)(F.ka->in[k]))
__device__ __forceinline__ int tid_now(int wave) { unsigned z = 0u; asm volatile("" : "+s"(z)); return (wave << 6) | (int)__builtin_amdgcn_mbcnt_hi(~0u, __builtin_amdgcn_mbcnt_lo(~0u, z)); }
__device__ __forceinline__ float modv(const Args& A, const Frame& F, int l, int bi, int n) {
    const float* P = (const float*)(F.ws + OFF_MODP); const int i = (l * 9 + bi) * 6144 + n;
    return P[i] + P[4 * 9 * 6144 + i] + IN(5)[l * 6144 + n];
}
__device__ __forceinline__ void transpose_item(const float* W, int K, int N, bf16_t* WT, LAS float* scr, int item, int lane) {
    const int nblk = N / 64, kb = item / nblk, nb = item % nblk, k0 = 64 * kb, n0 = 64 * nb;
#pragma unroll 16
    for (int i = 0; i < 64; ++i) scr[i * 65 + lane] = W[(size_t)(k0 + i) * N + n0 + lane];
    asm volatile("s_waitcnt lgkmcnt(0)" ::: "memory");
    const int c = lane & 7;
#pragma unroll
    for (int jj = 0; jj < 8; ++jj) { const int n = (lane >> 3) + 8 * jj; const LAS float* s = scr + (8 * c) * 65 + n;
        u32x4 o; o.x = cvt_pk_bf16(s[0], s[65]); o.y = cvt_pk_bf16(s[2 * 65], s[3 * 65]); o.z = cvt_pk_bf16(s[4 * 65], s[5 * 65]); o.w = cvt_pk_bf16(s[6 * 65], s[7 * 65]);
        *(u32x4*)(WT + (size_t)(n0 + n) * K + k0 + 8 * c) = o; }
    asm volatile("s_waitcnt lgkmcnt(0)" ::: "memory");
}
__device__ __forceinline__ void phase_pro0(const Args& A, Frame& F) {
    const float* c = IN(1); const float* c_ctx = IN(3); const float* mod_w = IN(4);
    {
        LAS float* scond = (LAS float*)F.lds;
        LAS float* red = (LAS float*)(F.lds + 9 * 512 * 4);
        float* MODP = (float*)(F.ws + OFF_MODP);
        for (int u = F.bx; u < 4 * 48 * 2; u += F.G) {
            const int kh = u & 1, cc = (u >> 1) % 48, l = (u >> 1) / 48, n0 = 128 * cc;
            __syncthreads();
            for (int i = F.tid; i < 9 * 512; i += NTHR) { const int bi = i >> 9, k = i & 511; const float x = bi < 8 ? c[bi * D + kh * 512 + k] : c_ctx[kh * 512 + k]; scond[i] = x / (1.f + expf(-x)); }
            __syncthreads();
            float a0[9], a1[9];
#pragma unroll
            for (int b = 0; b < 9; ++b) { a0[b] = 0.f; a1[b] = 0.f; }
            const float* wp = mod_w + ((size_t)l * D + kh * 512 + F.wave * 64) * 6144 + n0 + 2 * F.lane;
#pragma unroll 8
            for (int kk = 0; kk < 64; ++kk) { const f32x2 w = *(const f32x2*)(wp + (size_t)kk * 6144);
#pragma unroll
                for (int b = 0; b < 9; ++b) { const float s = scond[b * 512 + F.wave * 64 + kk]; a0[b] += s * w.x; a1[b] += s * w.y; } }
#pragma unroll
            for (int b = 0; b < 9; ++b) { red[(F.wave * 9 + b) * 128 + 2 * F.lane] = a0[b]; red[(F.wave * 9 + b) * 128 + 2 * F.lane + 1] = a1[b]; }
            __syncthreads();
            for (int i = F.tid; i < 9 * 128; i += NTHR) { const int b = i >> 7, col = i & 127; float s = 0.f;
#pragma unroll
                for (int w = 0; w < 8; ++w) s += red[(w * 9 + b) * 128 + col];
                MODP[(size_t)kh * 4 * 9 * 6144 + (l * 9 + b) * 6144 + n0 + col] = s; }
        }
        __syncthreads();
    }
    {
        float* rope = (float*)(F.ws + OFF_ROPE); float* sp = (float*)(F.ws + OFF_SP);
        const int gt = F.bx * NTHR + F.tid;
        if (gt < 1024) { const int pos = gt >> 4, f = gt & 15; const float inv = powf(10000.f, -(float)f / 16.f), ang = (float)pos * inv; rope[gt] = cosf(ang); rope[1024 + gt] = sinf(ang); }
        else if (gt < 1024 + 2048) { const int i = gt - 1024; sp[i] = log1pf(expf(-IN(27)[i])); }
    }
    {
        LAS float* scr = (LAS float*)(F.lds + F.wave * 16640);
        bf16_t* WT = (bf16_t*)(F.ws + OFF_WT);
        const int gw = F.vcu * NWAVES + F.wave, NGW = F.G * NWAVES;
        constexpr int I_W1 = 16 * 64, I_W2 = 64 * 16, I_QKV = 16 * 24, I_SQ = 16 * 16, I_2K = 16 * 32;
        constexpr int NITEMS = 4 * I_W1 + 4 * I_W2 + 2 * I_QKV + 2 * I_SQ + I_2K + I_SQ + I_2K + I_SQ;
        for (int it = gw; it < NITEMS; it += NGW) {
            int r = it;
            if (r < 4 * I_W1) { const int l = r / I_W1; transpose_item(IN(8) + (size_t)l * D * DFF, D, DFF, WT + WT_W1 + (size_t)l * D * DFF, scr, r % I_W1, F.lane); continue; } r -= 4 * I_W1;
            if (r < 4 * I_W2) { const int l = r / I_W2; transpose_item(IN(9) + (size_t)l * D * DFF, DFF, D, WT + WT_W2 + (size_t)l * D * DFF, scr, r % I_W2, F.lane); continue; } r -= 4 * I_W2;
            if (r < 2 * I_QKV) { const int j = r / I_QKV; transpose_item(IN(10) + (size_t)j * D * 1536, D, 1536, WT + WT_QKV + (size_t)j * D * 1536, scr, r % I_QKV, F.lane); continue; } r -= 2 * I_QKV;
            if (r < 2 * I_SQ) { const int j = r / I_SQ; transpose_item(IN(13) + (size_t)j * D * D, D, D, WT + WT_WO + (size_t)j * D * D, scr, r % I_SQ, F.lane); continue; } r -= 2 * I_SQ;
            if (r < I_2K) { transpose_item(IN(14), D, 2048, WT + WT_CIN, scr, r, F.lane); continue; } r -= I_2K;
            if (r < I_SQ) { transpose_item(IN(20), D, D, WT + WT_COUT, scr, r, F.lane); continue; } r -= I_SQ;
            if (r < I_2K) { transpose_item(IN(22), D, 2048, WT + WT_LIN, scr, r, F.lane); continue; } r -= I_2K;
            transpose_item(IN(28), D, D, WT + WT_LOUT, scr, r, F.lane);
        }
    }
}
__device__ __forceinline__ void phase_pro1(const Args& A, Frame& F) {
    {
        float* MODF = (float*)(F.ws + OFF_MODF); float* GAIN = (float*)(F.ws + OFF_GAIN);
        const int NT1 = 4 * 9 * 6144, NT2 = 4 * 2 * 9 * 1024;
        for (int i = F.bx * NTHR + F.tid; i < NT1 + NT2; i += F.G * NTHR) {
            if (i < NT1) { const int n = i % 6144, bi = (i / 6144) % 9, l = i / (6144 * 9); MODF[i] = modv(A, F, l, bi, n); }
            else { const int e = i - NT1, k = e & 1023, bi = (e >> 10) % 9, w = (e / 9216) & 1, l = e / 18432;
                GAIN[e] = (w ? IN(7) : IN(6))[l * D + k] * (1.f + modv(A, F, l, bi, (3 * w + 1) * D + k)); }
        }
    }
    {
        LAS bf16_t* shb = (LAS bf16_t*)F.lds;
        constexpr int SHP = 1024 + 8;
        float* SW = (float*)(F.ws + OFF_SW); const bf16_t* WT = (const bf16_t*)(F.ws + OFF_WT);
        constexpr int U_MLP = DFF / 128, U_QKV = 1536 / 128, U_2K = 2048 / 128, NU = 4 * U_MLP + 2 * U_QKV + 2 * U_2K;
        for (int u = F.bx; u < NU; u += F.G) {
            int r = u, l, w, N, cb; const bf16_t* Wt; const float* bias = nullptr; float* dst;
            if (r < 4 * U_MLP) { l = r / U_MLP; cb = r % U_MLP; w = 1; N = DFF; Wt = WT + WT_W1 + (size_t)l * D * DFF; dst = SW + SW_MLP + l * 9 * DFF; }
            else { r -= 4 * U_MLP;
                if (r < 2 * U_QKV) { const int j = r / U_QKV; l = 3 * j; cb = r % U_QKV; w = 0; N = 1536; Wt = WT + WT_QKV + (size_t)j * D * 1536; dst = SW + SW_QKV + j * 9 * 1536; }
                else { r -= 2 * U_QKV;
                    if (r < U_2K) { l = 1; cb = r; w = 0; N = 2048; Wt = WT + WT_CIN; bias = IN(15); dst = SW + SW_CIN; }
                    else { r -= U_2K; l = 2; cb = r; w = 0; N = 2048; Wt = WT + WT_LIN; dst = SW + SW_LIN; } } }
            __syncthreads();
            for (int i = F.tid; i < 16 * 1024; i += NTHR) { const int bi = i >> 10, k = i & 1023; shb[bi * SHP + k] = bi < 9 ? f2bf(modv(A, F, l, bi, (3 * w) * D + k)) : (bf16_t)0; }
            __syncthreads();
            const int n0 = cb * 128 + F.wave * 16, fr = F.lane & 15, fq = F.lane >> 4;
            const bf16_t* bp = Wt + (size_t)(n0 + fr) * D + 8 * fq;
            const LAS bf16_t* ap = shb + fr * SHP + 8 * fq;
            f32x4 acc = {0.f, 0.f, 0.f, 0.f};
            bf16x8 bfr[32];
#pragma unroll
            for (int ks = 0; ks < 32; ++ks) bfr[ks] = *(const bf16x8*)(bp + 32 * ks);
#pragma unroll
            for (int ks = 0; ks < 32; ++ks) acc = __builtin_amdgcn_mfma_f32_16x16x32_bf16(*(const LAS bf16x8*)(ap + 32 * ks), bfr[ks], acc, 0, 0, 0);
            const float bv = bias ? bias[n0 + fr] : 0.f;
#pragma unroll
            for (int rg = 0; rg < 4; ++rg) { const int bi = 4 * fq + rg; if (bi < 9) dst[bi * N + n0 + fr] = acc[rg] + bv; }
        }
        __syncthreads();
    }
    {
        LAS float* g0 = (LAS float*)F.lds;
        for (int i = F.tid; i < 9 * 1024; i += NTHR) g0[i] = IN(6)[i & 1023] * (1.f + modv(A, F, 0, i >> 10, D + (i & 1023)));
        __syncthreads();
        bf16_t* XG = (bf16_t*)(F.ws + OFF_XG); float* SSQ = (float*)(F.ws + OFF_SSQ);
        const int gw = F.vcu * NWAVES + F.wave, NGW = F.G * NWAVES;
        f32x4 nv[4];
#define XG0_LOAD(row_) do { const float* src_ = (row_) < ML ? IN(0) + (size_t)(row_) * D : IN(2) + (size_t)((row_) - ML) * D; \
            _Pragma("unroll") for (int j = 0; j < 4; ++j) nv[j] = ((const f32x4*)src_)[64 * j + F.lane]; } while (0)
        if (gw < M) XG0_LOAD(gw);
        for (int row = gw; row < M; row += NGW) {
            f32x4 v4[4];
#pragma unroll
            for (int j = 0; j < 4; ++j) v4[j] = nv[j];
            if (row + NGW < M) XG0_LOAD(row + NGW);
            const int bi = row < ML ? (row >> 11) : 8;
            float ss = 0.f;
#pragma unroll
            for (int j = 0; j < 4; ++j) { const f32x4 v = v4[j];
                ss += (v[0] * v[0] + v[1] * v[1]) + (v[2] * v[2] + v[3] * v[3]);
                const f32x4 gv = *(const LAS f32x4*)(g0 + bi * 1024 + 256 * j + 4 * F.lane);
                u32x2 w; w.x = cvt_pk_bf16(v[0] * gv[0], v[1] * gv[1]); w.y = cvt_pk_bf16(v[2] * gv[2], v[3] * gv[3]);
                *(u32x2*)(XG + (size_t)row * D + 256 * j + 4 * F.lane) = w; }
            ss = wave_sum(ss, F.lane);
            if (F.lane < 16) SSQ[(size_t)row * 16 + F.lane] = F.lane == 0 ? ss : 0.f;
        }
#undef XG0_LOAD
        __syncthreads();
    }
}

__device__ __forceinline__ void attn_phase(const Frame& F, char* lds_gen, bool lat_only) {
    bool nomax;
    { const int j = lat_only ? 1 : 0; float gq = fabsf(IN(11)[j * 64 + F.lane]), gk = fabsf(IN(12)[j * 64 + F.lane]);
#pragma unroll
      for (int m = 1; m < 64; m <<= 1) { gq = fmaxf(gq, shx(gq, m, F.lane)); gk = fmaxf(gk, shx(gk, m, F.lane)); }
      const float bound = 8.f * 1.4426950408889634f * 1.02f * gq * gk;
      nomax = __builtin_amdgcn_readfirstlane((int)(bound <= 64.f)) != 0; }
    const bf16_t* Q = (const bf16_t*)(F.ws + OFF_R1); bf16_t* O = (bf16_t*)(F.ws + OFF_R2);
    const bf16_t* Kb = (const bf16_t*)(F.ws + OFF_KV); const bf16_t* Vb = Kb + (size_t)BATCH * TKV * 256;
    const int total = lat_only ? 1024 : 1152, x = F.vcu >> 5, i = F.vcu & 31;
    for (int k = 0;; ++k) {
        int L;
        if (F.aff) { const int idx = k * F.xn + F.xr; L = idx < 128 ? F.xx * 128 + idx : (!lat_only && idx < 144) ? 1024 + F.xx * 16 + (idx - 128) : -1; }
        else if (F.G == 256) L = k < 4 ? x * 128 + k * 32 + i : (k == 4 && i < 16 && !lat_only) ? 1024 + x * 16 + i : -1;
        else { L = F.vcu + k * F.G; if (L >= total) L = -1; }
        if (L < 0) break;
        long qrow0, kvrow0; int h, NT;
        if (L < 1024) { const int b = L >> 7, kvh = (L >> 5) & 3, g = (L >> 3) & 3, qb = L & 7; h = kvh * 4 + g; qrow0 = (long)b * SEQ + qb * 256; kvrow0 = (long)b * TKV; NT = TKV / 64; }
        else { const int uc = L - 1024, b = uc >> 4; h = uc & 15; qrow0 = (long)ML + b * CTXL; kvrow0 = (long)b * TKV; NT = CTXL / 64; }
        if (nomax) attn_body::attn_unit<8, true>(F.tid, qrow0, h, kvrow0, NT, Q, Kb, Vb, O, lds_gen);
        else attn_body::attn_unit<8, false>(F.tid, qrow0, h, kvrow0, NT, Q, Kb, Vb, O, lds_gen);
    }
}
__device__ __forceinline__ void conv31_phase(const Args& A, const Frame& F) {
    const bf16_t* U = (const bf16_t*)(F.ws + OFF_R1); bf16_t* Y = (bf16_t*)(F.ws + OFF_R2);
    const int c0 = 2 * F.tid;
    f32x2 w[31];
#pragma unroll
    for (int k = 0; k < 31; ++k) w[k] = *(const f32x2*)(IN(16) + k * D + c0);
    const f32x2 bdw = *(const f32x2*)(IN(17) + c0), ng = *(const f32x2*)(IN(18) + c0), nb = *(const f32x2*)(IN(19) + c0);
    LAS float* red = (LAS float*)F.lds;
    LAS float* tot = (LAS float*)(F.lds + 1024);
    unsigned pks[46];
#define C31_LOAD(unit_) do { const int row0_ = (unit_) * 16; const int base_ = row0_ < ML ? (row0_ & ~(SEQ - 1)) : ML + ((row0_ - ML) & ~(CTXL - 1)), L_ = row0_ < ML ? SEQ : CTXL, t0_ = row0_ - base_; \
        _Pragma("unroll") for (int ir = 0; ir < 46; ++ir) { const int tt = t0_ + ir - 15, tc = tt < 0 ? 0 : (tt >= L_ ? L_ - 1 : tt); pks[ir] = *(const unsigned*)(U + (size_t)(base_ + tc) * D + c0); } } while (0)
    const int k0 = F.aff ? F.xr : F.bx, kstep = F.aff ? F.xn : F.G, kend = F.aff ? 144 : M / 16;
#define C31_UNIT(k_) (F.aff ? ((k_) < 128 ? F.xx * 128 + (k_) : 1024 + F.xx * 16 + ((k_) - 128)) : (k_))
    if (k0 < kend) C31_LOAD(C31_UNIT(k0));
    for (int kk = k0; kk < kend; kk += kstep) { const int unit = C31_UNIT(kk);
        const int row0 = unit * 16;
        const int base = row0 < ML ? (row0 & ~(SEQ - 1)) : ML + ((row0 - ML) & ~(CTXL - 1)), L = row0 < ML ? SEQ : CTXL, t0 = row0 - base;
        f32x2 acc[16];
#pragma unroll
        for (int tr = 0; tr < 16; ++tr) acc[tr] = bdw;
#pragma unroll
        for (int ir = 0; ir < 46; ++ir) {
            const int tt = t0 + ir - 15;
            const unsigned pk = (tt >= 0 && tt < L) ? pks[ir] : 0u;
            const f32x2 xv = {__uint_as_float(pk << 16), __uint_as_float(pk & 0xffff0000u)};
#pragma unroll
            for (int tr = 0; tr < 16; ++tr) { const int k = ir - tr; if (k >= 0 && k <= 30) acc[tr] += w[k] * xv; }
        }
        asm volatile("" ::: "memory");
        if (kk + kstep < kend) C31_LOAD(C31_UNIT(kk + kstep));
#pragma unroll
        for (int tr = 0; tr < 16; ++tr) {
            const float sv = wave_sum(acc[tr].x + acc[tr].y, F.lane), qv = wave_sum(acc[tr].x * acc[tr].x + acc[tr].y * acc[tr].y, F.lane);
            if (F.lane == 0) { red[F.wave * 32 + tr] = sv; red[F.wave * 32 + 16 + tr] = qv; }
        }
        asm volatile("s_waitcnt lgkmcnt(0)" ::: "memory"); __builtin_amdgcn_s_barrier(); asm volatile("" ::: "memory");
        if (F.tid < 32) { float v = 0.f;
#pragma unroll
            for (int ww = 0; ww < 8; ++ww) v += red[ww * 32 + F.tid];
            tot[F.tid] = v; }
        asm volatile("s_waitcnt lgkmcnt(0)" ::: "memory"); __builtin_amdgcn_s_barrier(); asm volatile("" ::: "memory");
#pragma unroll
        for (int tr = 0; tr < 16; ++tr) {
            const float mean = tot[tr] * (1.f / D), var = tot[16 + tr] * (1.f / D) - mean * mean, rstd = rsqrtf(var + EPS);
            const float y0 = (acc[tr].x - mean) * rstd * ng.x + nb.x, y1 = (acc[tr].y - mean) * rstd * ng.y + nb.y;
            *(unsigned*)(Y + (size_t)(row0 + tr) * D + c0) = cvt_pk_bf16(y0 * fast_sigmoid(y0), y1 * fast_sigmoid(y1));
        }
    }
#undef C31_LOAD
#undef C31_UNIT
    __syncthreads();
}
__device__ __forceinline__ void conv4_phase(const Args& A, const Frame& F) {
    const bf16_t* XB = (const bf16_t*)(F.ws + OFF_R2);
    const int gthreads = (F.aff ? F.xn : F.G) * NTHR, gid = (F.aff ? F.xr : F.bx) * NTHR + F.tid;
    const int iend = F.aff ? 288 * 128 : (M / 8) * 128;
    const int cg = gid & 127, c0 = 8 * cg;
    f32x4 wf[4][2], wb[4][2], bf_[2], bb_[2];
#pragma unroll
    for (int k = 0; k < 4; ++k)
#pragma unroll
        for (int hh = 0; hh < 2; ++hh) { wf[k][hh] = *(const f32x4*)(IN(23) + (0 * 4 + k) * D + c0 + 4 * hh); wb[k][hh] = *(const f32x4*)(IN(23) + (1 * 4 + k) * D + c0 + 4 * hh); }
#pragma unroll
    for (int hh = 0; hh < 2; ++hh) { bf_[hh] = *(const f32x4*)(IN(24) + c0 + 4 * hh); bb_[hh] = *(const f32x4*)(IN(24) + D + c0 + 4 * hh); }
    for (int idx = gid; idx < iend; idx += gthreads) {
        const int blk_ = idx >> 7, r0 = (F.aff ? (blk_ < 256 ? F.xx * 256 + blk_ : 2048 + F.xx * 32 + (blk_ - 256)) : blk_) * 8;
        const bool cx_ = r0 >= ML; const int bb4 = cx_ ? (r0 - ML) >> 8 : r0 >> 11;
        bf16_t* UF = (bf16_t*)lru_base(F.ws, 1, bb4, cx_); bf16_t* UB = (bf16_t*)lru_base(F.ws, 2, bb4, cx_);
        u32x4 p[14];
#pragma unroll
        for (int i = 0; i < 14; ++i) { int rr = r0 - 3 + i; rr = rr < 0 ? 0 : (rr > M - 1 ? M - 1 : rr); p[i] = *(const u32x4*)(XB + (size_t)rr * D + c0); }
#pragma unroll
        for (int o = 0; o < 8; ++o) {
            const int row = r0 + o;
            const int t = row < ML ? (row & (SEQ - 1)) : ((row - ML) & (CTXL - 1)), L = row < ML ? SEQ : CTXL;
            f32x4 vf[2] = {bf_[0], bf_[1]}, vb[2] = {bb_[0], bb_[1]};
#pragma unroll
            for (int dt = 0; dt < 7; ++dt) { const int tt = t + dt - 3;
                if (tt >= 0 && tt < L) { const u32x4 q = p[o + dt];
                    const f32x4 x0 = {__uint_as_float(q.x << 16), __uint_as_float(q.x & 0xffff0000u), __uint_as_float(q.y << 16), __uint_as_float(q.y & 0xffff0000u)};
                    const f32x4 x1 = {__uint_as_float(q.z << 16), __uint_as_float(q.z & 0xffff0000u), __uint_as_float(q.w << 16), __uint_as_float(q.w & 0xffff0000u)};
                    if (dt <= 3) { vf[0] += wf[dt][0] * x0; vf[1] += wf[dt][1] * x1; }
                    if (dt >= 3) { vb[0] += wb[6 - dt][0] * x0; vb[1] += wb[6 - dt][1] * x1; } } }
            u32x4 of, ob;
            of.x = cvt_pk_bf16(vf[0][0], vf[0][1]); of.y = cvt_pk_bf16(vf[0][2], vf[0][3]); of.z = cvt_pk_bf16(vf[1][0], vf[1][1]); of.w = cvt_pk_bf16(vf[1][2], vf[1][3]);
            ob.x = cvt_pk_bf16(vb[0][0], vb[0][1]); ob.y = cvt_pk_bf16(vb[0][2], vb[0][3]); ob.z = cvt_pk_bf16(vb[1][0], vb[1][1]); ob.w = cvt_pk_bf16(vb[1][2], vb[1][3]);
            *(u32x4*)(UF + (size_t)row * D + c0) = of; *(u32x4*)(UB + (size_t)row * D + c0) = ob;
        }
    }
}
typedef float f32x16 __attribute__((ext_vector_type(16)));
template <int DIR>
__device__ __forceinline__ void lru_dir(const Frame& F, int b, int n, int sl) {
    const int lane = F.lane, w = F.wave, col = lane & 31, hi = lane >> 5;
    const int ch = 256 * n + 32 * sl + col;
    const bf16_t* Ul = (const bf16_t*)lru_base(F.ws, DIR ? 2 : 1, b, false); const bf16_t* Uc = (const bf16_t*)lru_base(F.ws, DIR ? 2 : 1, b, true);
    float* HFl = (float*)lru_base(F.ws, 0, b, false); float* HFc = (float*)lru_base(F.ws, 0, b, true); const bf16_t* Gb = (const bf16_t*)(F.ws + OFF_R1); bf16_t* Y = (bf16_t*)(F.ws + OFF_R2);
    LAS unsigned char* WL = F.lds;
    LAS f32x2* CAR = (LAS f32x2*)(F.lds + 34816);
    __syncthreads();
    { const float* gw = IN(25);
#pragma unroll 1
      for (int e0 = 0; e0 < 32; e0 += 16) { float wv[16];
#pragma unroll
        for (int e = 0; e < 16; ++e) { const int idx = F.tid + NTHR * (e0 + e), g = idx >> 13, k = (idx >> 5) & 255, c = idx & 31;
            wv[e] = gw[((size_t)((DIR * 2 + g) * 4 + n) * 256 + k) * 256 + 32 * sl + c]; }
#pragma unroll
        for (int e = 0; e < 16; ++e) { const int idx = F.tid + NTHR * (e0 + e), g = idx >> 13, k = (idx >> 5) & 255, c = idx & 31;
            *(LAS bf16_t*)(WL + (g * 32 + c) * 528 + k * 2) = f2bf(wv[e]); } } }
    __syncthreads();
    const float br = IN(26)[(DIR * 2 + 0) * D + ch], bi = IN(26)[(DIR * 2 + 1) * D + ch];
    const float spv = ((const float*)(F.ws + OFF_SP))[DIR * D + ch] * (-8.f * 1.4426950408889634f);
    const unsigned vo_p = (unsigned)((lane >> 4) * D + 8 * (lane & 15)) * 2u;
    LAS unsigned char* AS = F.lds + 40960 + w * 8704;
    const unsigned vo_e = (unsigned)(4 * hi * D + col);
    float Hrun = 0.f;
    u32x4 pf[2][8];
#define LRU_ROW0(step_) ((step_) == 0 ? ML + b * CTXL : b * SEQ + 256 * (DIR ? 8 - (step_) : (step_) - 1))
#define LRU_UOFF(row0_, r_) ((size_t)((row0_) + 32 * w + ((r_) & 3) + 8 * ((r_) >> 2)) * D + 256 * n + 32 * sl)
#define LRU_PREFETCH(step_, hf_) do { const int row0_ = LRU_ROW0(step_); \
        const bf16_t* ua_ = ((step_) == 0 ? Uc : Ul) + (size_t)(row0_ + 32 * w) * D + 256 * n; \
        _Pragma("unroll") for (int j = 0; j < 8; ++j) pf[hf_][j] = ldu<u32x4>(ua_ + (size_t)(4 * j) * D + 128 * (hf_), vo_p); } while (0)
    LRU_PREFETCH(0, 0); LRU_PREFETCH(0, 1);
    for (int step = 0; step < 9; ++step) {
        const int row0 = LRU_ROW0(step);
        float hfv[16]; bf16_t gv[16];
        if (DIR == 1) {
#pragma unroll
            for (int r = 0; r < 16; ++r) { hfv[r] = ldu<float>((step == 0 ? HFc : HFl) + LRU_UOFF(row0, r), vo_e * 4u); gv[r] = ldu<bf16_t>(Gb + LRU_UOFF(row0, r), vo_e * 2u); }
        }
        f32x16 ar, ai;
#pragma unroll
        for (int r = 0; r < 16; ++r) { ar[r] = 0.f; ai[r] = 0.f; }
        const LAS unsigned char* wp = WL + col * 528 + 16 * hi;
        bf16_t uc[16];
#pragma unroll
        for (int hf = 0; hf < 2; ++hf) {
#pragma unroll
            for (int j = 0; j < 8; ++j) *(LAS u32x4*)(AS + (4 * j + (lane >> 4)) * 272 + (lane & 15) * 16) = pf[hf][j];
            asm volatile("" ::: "memory");
            if (step + 1 < 9) LRU_PREFETCH(step + 1, hf);
            bf16x8 af_c = *(const LAS bf16x8*)(AS + col * 272 + 16 * hi), wr_c = *(const LAS bf16x8*)(wp + 32 * (8 * hf)), wi_c = *(const LAS bf16x8*)(wp + 32 * 528 + 32 * (8 * hf));
#pragma unroll
            for (int k8 = 0; k8 < 8; ++k8) { const int ks = 8 * hf + k8 + 1;
                bf16x8 af_n = af_c, wr_n = wr_c, wi_n = wi_c;
                if (k8 < 7) { af_n = *(const LAS bf16x8*)(AS + col * 272 + 32 * (k8 + 1) + 16 * hi); wr_n = *(const LAS bf16x8*)(wp + 32 * ks); wi_n = *(const LAS bf16x8*)(wp + 32 * 528 + 32 * ks); }
                ar = __builtin_amdgcn_mfma_f32_32x32x16_bf16(af_c, wr_c, ar, 0, 0, 0); ai = __builtin_amdgcn_mfma_f32_32x32x16_bf16(af_c, wi_c, ai, 0, 0, 0);
                af_c = af_n; wr_c = wr_n; wi_c = wi_n; }
            if (hf == (sl >> 2)) {
#pragma unroll
                for (int r = 0; r < 16; ++r) uc[r] = *(const LAS bf16_t*)(AS + ((r & 3) + 8 * (r >> 2) + 4 * hi) * 272 + ((32 * sl + col) & 127) * 2);
            }
        }
        float a[16], hb[16];
#pragma unroll
        for (int r = 0; r < 16; ++r) {
            const int tk = 32 * w + (r & 3) + 8 * (r >> 2) + 4 * hi;
            const float rr = fast_sigmoid(ar[r] + br), ii = fast_sigmoid(ai[r] + bi);
            const float av = __builtin_amdgcn_exp2f(spv * rr);
            float mult = __builtin_amdgcn_sqrtf(fmaxf(1.f - av * av, 0.f));
            if (step == 0 && tk == (DIR ? 255 : 0)) mult = 1.f;
            a[r] = av; hb[r] = mult * ii * bf2f(uc[r]);
        }
        float Aq[4], Bq[4], pA[4], pB[4];
#pragma unroll
        for (int q = 0; q < 4; ++q) { float H = 0.f, Ac = 1.f;
#pragma unroll
            for (int ee = 0; ee < 4; ++ee) { const int r = 4 * q + (DIR ? 3 - ee : ee); H = a[r] * H + hb[r]; Ac *= a[r]; hb[r] = H; a[r] = Ac; }
            Aq[q] = Ac; Bq[q] = H; pA[q] = other_half(Ac, hi); pB[q] = other_half(H, hi); }
        float Ac = 1.f, Hc = 0.f, Ain[4], Hin[4];
        const bool mine_first = DIR ? (hi == 1) : (hi == 0);
#pragma unroll
        for (int qq = 0; qq < 4; ++qq) { const int q = DIR ? 3 - qq : qq;
            const float A0 = mine_first ? Aq[q] : pA[q], B0 = mine_first ? Bq[q] : pB[q], A1 = mine_first ? pA[q] : Aq[q], B1 = mine_first ? pB[q] : Bq[q];
            const float i0A = Ac, i0H = Hc; Hc = A0 * Hc + B0; Ac *= A0;
            const float i1A = Ac, i1H = Hc; Hc = A1 * Hc + B1; Ac *= A1;
            Ain[q] = mine_first ? i0A : i1A; Hin[q] = mine_first ? i0H : i1H; }
#pragma unroll
        for (int r = 0; r < 16; ++r) { hb[r] += a[r] * Hin[r >> 2]; a[r] *= Ain[r >> 2]; }
        const int buf = step & 1;
        if (hi == 0) CAR[(buf * 8 + w) * 32 + col] = (f32x2){Ac, Hc};
        asm volatile("s_waitcnt lgkmcnt(0)" ::: "memory"); __builtin_amdgcn_s_barrier(); asm volatile("" ::: "memory");
        float S = Hrun, HinG = 0.f;
#pragma unroll
        for (int jj = 0; jj < 8; ++jj) { const int j = DIR ? 7 - jj : jj; const f32x2 c = CAR[(buf * 8 + j) * 32 + col]; if (j == w) HinG = S; S = c.x * S + c.y; }
        Hrun = S;
#pragma unroll
        for (int r = 0; r < 16; ++r) {
            const float h = hb[r] + a[r] * HinG;
            if (DIR == 0) stu<float>((step == 0 ? HFc : HFl) + LRU_UOFF(row0, r), vo_e * 4u, h); else stu<bf16_t>(Y + LRU_UOFF(row0, r), vo_e * 2u, f2bf((hfv[r] + h) * bf2f(gv[r])));
        }
    }
}
__device__ __forceinline__ void lru_phase(const Frame& F) {
    if (F.aff) { for (int k = F.xr; k < 32; k += F.xn) { const int b = F.xx, n = (k >> 3) & 3, sl = k & 7; lru_dir<0>(F, b, n, sl); lru_dir<1>(F, b, n, sl); } }
    else for (int u = F.vcu; u < BATCH * 4 * 8; u += F.G) { const int b = u >> 5, n = (u >> 3) & 3, sl = u & 7; lru_dir<0>(F, b, n, sl); lru_dir<1>(F, b, n, sl); }
#undef LRU_PREFETCH
#undef LRU_ROW0
#undef LRU_UOFF
    __syncthreads();
}
enum { PH_PRO0 = 0, PH_PRO1 = 1, PH_L0 = 2 };
constexpr int N_PHASES = 23;
enum { ST_QKV = 0, ST_ATT, ST_OUT, ST_UP, ST_DOWN, ST_CIN, ST_CONV, ST_LIN, ST_CONV4, ST_SCAN };
__device__ __forceinline__ int stage_of(int l, int s) {
    if (l == 1) return s == 0 ? ST_CIN : s == 1 ? ST_CONV : s == 2 ? ST_OUT : s == 3 ? ST_UP : ST_DOWN;
    if (l == 2) return s == 0 ? ST_LIN : s == 1 ? ST_CONV4 : s == 2 ? ST_SCAN : s == 3 ? ST_OUT : s == 4 ? ST_UP : ST_DOWN;
    return s == 0 ? ST_QKV : s == 1 ? ST_ATT : s == 2 ? ST_OUT : s == 3 ? ST_UP : ST_DOWN;
}
__device__ __forceinline__ int gemm_descs(const Args& A, const Frame& F, int l, int st, pg8::Gemm& g, pg8::Sched& S, pg8::Epi& E) {
    bf16_t* WT = (bf16_t*)(F.ws + OFF_WT); bf16_t* XG = (bf16_t*)(F.ws + OFF_XG); bf16_t* Hb = (bf16_t*)(F.ws + OFF_BIG);
    bf16_t* R1 = (bf16_t*)(F.ws + OFF_R1); bf16_t* R2 = (bf16_t*)(F.ws + OFF_R2);
    bf16_t* Kb = (bf16_t*)(F.ws + OFF_KV); bf16_t* Vb = Kb + (size_t)BATCH * TKV * 256;
    float* SSQ = (float*)(F.ws + OFF_SSQ); const float* MODF = (const float*)(F.ws + OFF_MODF); const float* GAIN = (const float*)(F.ws + OFF_GAIN); const float* SW = (const float*)(F.ws + OFF_SW);
    const bool lat_only = l == 3; const int j = l / 3;
    const bool up = st == ST_UP, down = st == ST_DOWN, outp = st == ST_OUT, qkv = st == ST_QKV, cin = st == ST_CIN, lin = st == ST_LIN;
    const int ek = up ? pg8::EK_MLP1 : down ? (l == 3 ? pg8::EK_RES : pg8::EK_RES2) : outp ? (l == 0 ? pg8::EK_RESO : pg8::EK_RESO2) : qkv ? pg8::EK_QKV : cin ? pg8::EK_GLU : lin ? pg8::EK_LRUIN : 0;
    const size_t wt_off = up ? WT_W1 + (size_t)l * D * DFF : down ? WT_W2 + (size_t)l * D * DFF : outp ? (l == 1 ? WT_COUT : l == 2 ? WT_LOUT : WT_WO + (size_t)j * D * D)
                        : qkv ? WT_QKV + (size_t)j * D * 1536 : cin ? WT_CIN : WT_LIN;
    g.A = down ? Hb : outp ? R2 : XG; g.Bt = WT + wt_off; g.K = down ? DFF : D;
    g.tstepB = (cin ? 128L : 256L) * g.K * 2; g.hstepB = (cin ? 1024L : qkv ? 16L : 128L) * g.K * 2; g.bmap = qkv ? 1 : 0;
    S.nM0 = lat_only ? 64 : 72; S.nN0 = up ? 16 : (down || outp) ? 4 : qkv ? 6 : 8; S.pm00 = 0; S.pn00 = 0;
    const bool two = qkv && lat_only; S.nM1 = two ? 8 : 0; S.nN1 = two ? 2 : 0; S.pm01 = 64; S.pn01 = 4; S.G = F.G; S.c = F.bx;
    S.aff = F.aff; S.xx = F.xx; S.xr = F.xr; S.xn = F.xn; S.nctx = lat_only ? (qkv ? 2 : 0) : S.nN0;
    E.kind = ek; E.ssq = SSQ; E.N = up ? DFF : qkv ? 1536 : 2048;
    E.sw = SW + (up ? SW_MLP + l * 9 * DFF : qkv ? SW_QKV + j * 9 * 1536 : cin ? SW_CIN : SW_LIN);
    E.o0 = up ? Hb : R1; E.o1 = qkv ? Kb : R2; E.o2 = Vb;
    E.xl = F.out; E.xc = (float*)(F.ws + OFF_XC); E.xg = XG; E.ssq_out = SSQ;
    const bool first_res = outp && l == 0;
    E.xrl = first_res ? IN(0) : (const float*)F.out; E.xrc = first_res ? IN(2) : (const float*)(F.ws + OFF_XC);
    E.xmb = R1; E.xmid = outp ? 1 : down ? 2 : 0; E.xbl = (bf16_t*)F.out; E.xbc = (bf16_t*)(F.ws + OFF_XC);
    E.gate = MODF + (size_t)l * 9 * 6144 + (down ? 5 * D : 2 * D);
    E.bias = (outp && l == 1) ? IN(21) : nullptr;
    E.gain = down ? (l < 3 ? GAIN + (size_t)((l + 1) * 2 + 0) * 9 * D : nullptr) : GAIN + (size_t)(l * 2 + 1) * 9 * D;
    E.qg = IN(11) + j * 64; E.kg = IN(12) + j * 64; E.rope = (const float*)(F.ws + OFF_ROPE);
    return ek;
}

namespace chain {
using namespace pg8;
enum { T_OUT = 0, T_UP = 1, T_DOWN = 2, T_IN = 3 };
constexpr int Q_OFF_WORDS = 16384, C_OFF_WORDS = 32768, MB_POS = 16, MB_RDY = 17, MB_NEXT = 18, END = 1 << 20;
struct Ctx { int l, P, nin, qkv3, x, nlist, pos0, nodeps; unsigned* head; unsigned* cnt; };
__device__ __forceinline__ void decode(const Ctx& c0, int pos, int& type, int& pm, int& pn) {
    int l_ = c0.l; asm volatile("" : "+s"(l_));
    struct { int P, nin, qkv3, x; } c; c.P = l_ == 3 ? 8 : 9; c.qkv3 = l_ == 2; c.nin = l_ == 3 ? 0 : (l_ == 2 ? 6 : 8); c.x = c0.x;
    int j;
    if (c.P == 9) {
        if (pos < 4) { type = T_OUT; j = 8; pn = pos; }
        else if (pos < 36) { type = T_OUT; j = (pos - 4) >> 2; pn = (pos - 4) & 3; }
        else if (pos < 52) { type = T_UP; j = 8; pn = pos - 36; }
        else if (pos < 184) { const int q = pos - 52;
            if (q < 32) { type = T_UP; j = q >> 2; pn = q & 3; }
            else if (q < 36) { type = T_DOWN; j = 8; pn = q - 32; }
            else { const int q2 = q - 36, cg = 1 + (q2 >> 5), r = q2 & 31; type = T_UP; j = r >> 2; pn = 4 * cg + (r & 3); } }
        else if (pos < 216) { type = T_DOWN; j = (pos - 184) >> 2; pn = (pos - 184) & 3; }
        else { int q = pos - 216; const int nin8 = c.qkv3 ? 2 : c.nin; type = T_IN;
            if (q < nin8) { j = 8; pn = c.qkv3 ? 4 + q : q; } else { q -= nin8; j = q / c.nin; pn = q % c.nin; } }
    } else {
        const int nO = 4 * c.P, nU = 16 * c.P, nD = 4 * c.P;
        if (pos < nO) { type = T_OUT; j = pos >> 2; pn = pos & 3; }
        else if (pos < nO + nU) { const int q = pos - nO, cg = q / nO, r = q % nO; type = T_UP; j = r >> 2; pn = 4 * cg + (r & 3); }
        else if (pos < nO + nU + nD) { const int q = pos - nO - nU; type = T_DOWN; j = q >> 2; pn = q & 3; }
        else { const int q = pos - nO - nU - nD; type = T_IN; j = q / c.nin; pn = q % c.nin; }
    }
    pm = j < 8 ? 8 * c.x + j : 64 + c.x;
}
__device__ __forceinline__ unsigned* dep_word(const Ctx& c, int type, int pm, unsigned& need) {
    need = type == T_UP ? 32u : type == T_DOWN ? 128u : type == T_IN ? 32u : 0u;
    if (c.nodeps) need = 0u;
    if (c.l == 3 && type == T_UP && !c.nodeps) { need = 256u; return c.cnt + (14 * 72 + c.x) * 16; }
    return c.cnt + ((c.l * 3 + (type > 0 ? type - 1 : 0)) * 72 + pm) * 16;
}
__device__ __forceinline__ int unit_descs(const Args& A, const Frame& F, int l, int type, Gemm& g, Epi& E) {
    Sched S;
    const int le = type == T_IN ? l + 1 : l;
    const int st = type == T_OUT ? ST_OUT : type == T_UP ? ST_UP : type == T_DOWN ? ST_DOWN : (l == 0 ? ST_CIN : l == 1 ? ST_LIN : ST_QKV);
    return gemm_descs(A, F, le, st, g, S, E);
}
struct Stg { const char* A; const char* B; int K; long hB, tB; int bmap; };
__device__ __forceinline__ Stg unit_stage(const Args& A, const Frame& F, int l, int type) {
    Gemm g; Epi E; (void)unit_descs(A, F, l, type, g, E);
    Stg s; s.A = (const char*)g.A; s.B = (const char*)g.Bt; s.K = g.K; s.hB = g.hstepB; s.tB = g.tstepB; s.bmap = g.bmap; return s;
}
__device__ __forceinline__ int stream(const Args& A, const Frame& F, const Ctx& c, LAS unsigned char* lds, volatile LAS unsigned* MISC, const int pos0) {
    const int wid = F.wave, wr = wid >> 2, wc = wid & 3;
    int tid = tid_now(F.wave);
    int lane = tid & 63, fr = lane & 15, fq = lane >> 4;
#define CH_VOFF(vA_, vB_, K_, bm_) do { _Pragma("unroll") for (int _i = 0; _i < 2; ++_i) { int R_, C_; stage_rc(tid * 16 + _i * 8192, R_, C_); \
        const int Rb_ = (bm_) ? qkvmap(R_) : ((R_ & ~31) + perm32(R_ & 31)); vA_[_i] = (unsigned)(R_ * (K_) + C_) * 2u; vB_[_i] = (unsigned)(Rb_ * (K_) + C_) * 2u; } } while (0)
    const unsigned ldsw = (unsigned)wid * 1024u;
    int aoff = lds_byte(wr * 64 + fr, fq * 8), boff = lds_byte(wc * 32 + fr, fq * 8);
    const size_t kstep = (size_t)(BK * 2);
#define PG8_SA(b, h) (((b) * 2 + (h)) * HTB)
#define PG8_SB(b, h) ((4 + (b) * 2 + (h)) * HTB)
#define CH_STAGE_A(bufoff, gbase) do { _Pragma("unroll") for (int _i = 0; _i < 2; ++_i) \
        __builtin_amdgcn_global_load_lds((const unsigned*)((const char*)(gbase) + vA[_i]), (LAS unsigned*)(lds + (bufoff) + ldsw + _i * 8192), 16, 0, 0); } while (0)
#define CH_STAGE_B(bufoff, gbase) do { _Pragma("unroll") for (int _i = 0; _i < 2; ++_i) \
        __builtin_amdgcn_global_load_lds((const unsigned*)((const char*)(gbase) + vB[_i]), (LAS unsigned*)(lds + (bufoff) + ldsw + _i * 8192), 16, 0, 0); } while (0)
#define PG8_LDA(dst, b, h) do { _Pragma("unroll") for (int m = 0; m < 4; ++m) _Pragma("unroll") for (int k = 0; k < 2; ++k) dst[m][k] = *(const LAS bf16x8*)(lds + PG8_SA(b, h) + aoff + m * 2048 + k * 1024); } while (0)
#define PG8_LDB(dst, b, h) do { _Pragma("unroll") for (int n = 0; n < 2; ++n) _Pragma("unroll") for (int k = 0; k < 2; ++k) dst[n][k] = *(const LAS bf16x8*)(lds + PG8_SB(b, h) + boff + n * 2048 + k * 1024); } while (0)
#define PG8_MMA(ai, bj, At, Bt) do { __builtin_amdgcn_s_setprio(1); _Pragma("unroll") for (int m = 0; m < 4; ++m) _Pragma("unroll") for (int n = 0; n < 2; ++n) _Pragma("unroll") for (int k = 0; k < 2; ++k) \
        acc[ai][bj][m][n] = __builtin_amdgcn_mfma_f32_16x16x32_bf16(Bt[n][k], At[m][k], acc[ai][bj][m][n], 0, 0, 0); __builtin_amdgcn_s_setprio(0); } while (0)
#define PG8_WAIT_V(n) asm volatile("s_waitcnt vmcnt(" #n ")" ::: "memory")
#define PG8_WAIT_L(n) asm volatile("s_waitcnt lgkmcnt(" #n ")" ::: "memory")
#define PG8_BAR __builtin_amdgcn_s_barrier()
#define PG8_SCHED __builtin_amdgcn_sched_barrier(0)
    int type, pm, pn; decode(c, pos0, type, pm, pn);
    int Kc; unsigned vA[2], vB[2]; size_t hA, hB; const char* cA; const char* cB;
    { const Stg s0 = unit_stage(A, F, c.l, type); Kc = s0.K; CH_VOFF(vA, vB, Kc, s0.bmap); hA = (size_t)HALF * Kc * 2; hB = (size_t)s0.hB;
      cA = s0.A + (size_t)pm * 2 * hA; cB = s0.B + (size_t)pn * (size_t)s0.tB; }
    f32x4 acc[2][2][4][2];
#pragma unroll
    for (int a = 0; a < 2; ++a)
#pragma unroll
        for (int b = 0; b < 2; ++b)
#pragma unroll
            for (int m = 0; m < 4; ++m)
#pragma unroll
                for (int n = 0; n < 2; ++n) acc[a][b][m][n] = (f32x4){0.f, 0.f, 0.f, 0.f};
    bf16x8 At[4][2], B0[2][2], B1[2][2];
    CH_STAGE_B(PG8_SB(0, 0), cB); CH_STAGE_B(PG8_SB(0, 1), cB + hB); CH_STAGE_A(PG8_SA(0, 0), cA); CH_STAGE_A(PG8_SA(0, 1), cA + hA);
    if (wr == 1) PG8_BAR;
    PG8_WAIT_V(2); PG8_BAR;
    CH_STAGE_B(PG8_SB(1, 0), cB + kstep); CH_STAGE_A(PG8_SA(1, 0), cA + kstep); CH_STAGE_B(PG8_SB(1, 1), cB + hB + kstep);
    PG8_WAIT_V(6); PG8_BAR;
    int ret = END;
    for (;;) {
        const int nt = Kc / BK;
        { asm volatile("" : "+v"(vA[0]), "+v"(vA[1]), "+v"(vB[0]), "+v"(vB[1])); tid = tid_now(F.wave); lane = tid & 63; fr = lane & 15; fq = lane >> 4;
          aoff = lds_byte(wr * 64 + fr, fq * 8); boff = lds_byte(wc * 32 + fr, fq * 8); }
        bool stream_on = false; int npos = END;
        const char* nA = cA; const char* nB = cB; int Kn = Kc; size_t hAn = hA, hBn = hB;
        int ntype = 0, npm = 0, npn = 0;
        unsigned depv = 0u;
        for (int t = 0; t < nt; t += 2) {
            const bool last = (t == nt - 2);
            const char* a1 = cA + (size_t)(t + 1) * kstep;
            const char* a2 = cA + (size_t)(t + 2) * kstep; const char* b2 = cB + (size_t)(t + 2) * kstep;
            if (wid == 0 && (t == nt - 4 || last)) {
                const int np = __builtin_amdgcn_readfirstlane((int)MISC[MB_NEXT]);
                unsigned need = 0u; unsigned* dw = c.cnt;
                if (np < c.nlist) { int ty, p_, q_; decode(c, np, ty, p_, q_); dw = dep_word(c, ty, p_, need); }
                if (!last) { if (need) depv = __hip_atomic_load(dw, __ATOMIC_RELAXED, __HIP_MEMORY_SCOPE_AGENT); }
                else { const unsigned dv = (unsigned)__builtin_amdgcn_readfirstlane((int)depv);
                    if (lane == 0) MISC[MB_RDY] = (dv >= need) ? 1u : 0u;
                    asm volatile("s_waitcnt lgkmcnt(0)" ::: "memory"); }
            }
            if (last) {
                asm volatile("" ::: "memory"); PG8_BAR; asm volatile("" ::: "memory");
                npos = __builtin_amdgcn_readfirstlane((int)MISC[MB_NEXT]); const int rdy = __builtin_amdgcn_readfirstlane((int)MISC[MB_RDY]);
                stream_on = (npos < c.nlist) && rdy != 0;
                if (stream_on && type != T_IN && npos >= 24 * c.P) stream_on = false;
                a2 = cA; b2 = cB;
            }
            PG8_LDB(B0, 0, 0); PG8_LDB(B1, 0, 1); PG8_SCHED; PG8_LDA(At, 0, 0); CH_STAGE_A(PG8_SA(1, 1), a1 + hA);
            if (last && stream_on) {
                decode(c, npos, ntype, npm, npn); const Stg sn = unit_stage(A, F, c.l, ntype);
                Kn = sn.K; CH_VOFF(vA, vB, Kn, sn.bmap); hAn = (size_t)HALF * Kn * 2; hBn = (size_t)sn.hB;
                nA = sn.A + (size_t)npm * 2 * hAn; nB = sn.B + (size_t)npn * (size_t)sn.tB;
                hA = hAn; hB = hBn; a2 = nA; b2 = nB;
            }
            const char* a3 = a2 + kstep; const char* b3 = b2 + kstep;
            PG8_WAIT_V(8); PG8_WAIT_L(0); PG8_BAR; PG8_MMA(0, 0, At, B0); PG8_MMA(0, 1, At, B1); PG8_BAR; PG8_SCHED;
            PG8_LDA(At, 0, 1); CH_STAGE_B(PG8_SB(0, 0), b2); CH_STAGE_B(PG8_SB(0, 1), b2 + hB); CH_STAGE_A(PG8_SA(0, 0), a2);
            PG8_WAIT_V(8); PG8_WAIT_L(0); PG8_BAR; PG8_MMA(1, 0, At, B0); PG8_MMA(1, 1, At, B1); PG8_BAR; PG8_SCHED;
            PG8_LDB(B0, 1, 0); PG8_LDB(B1, 1, 1); PG8_SCHED; PG8_LDA(At, 1, 0); CH_STAGE_A(PG8_SA(0, 1), a2 + hA);
            PG8_WAIT_V(8); PG8_WAIT_L(0); PG8_BAR; PG8_MMA(0, 0, At, B0); PG8_MMA(0, 1, At, B1); PG8_BAR; PG8_SCHED;
            PG8_LDA(At, 1, 1); CH_STAGE_B(PG8_SB(1, 0), b3); CH_STAGE_B(PG8_SB(1, 1), b3 + hB); CH_STAGE_A(PG8_SA(1, 0), a3);
            PG8_WAIT_V(8); PG8_WAIT_L(0); PG8_BAR; PG8_MMA(1, 0, At, B0); PG8_MMA(1, 1, At, B1); PG8_BAR; PG8_SCHED;
        }
        if (wr == 0) PG8_BAR;
        unsigned nposv = 0u;
        if (stream_on && tid_now(F.wave) == 0) nposv = c.pos0 + __hip_atomic_fetch_add(c.head, 1u, __ATOMIC_RELAXED, __HIP_MEMORY_SCOPE_AGENT);
        { const Unit cur{pm, pn}; Gemm g; Epi E; const int ek = unit_descs(A, F, c.l, type, g, E);
          const int ln = tid_now(F.wave) & 63;
          const int fr_ = ln & 15, fq_ = ln >> 4;
          switch (ek) {
          case EK_MLP1: epilogue<EK_MLP1>(lds, E, acc, cur, wr, wc, fr_, fq_); break;
          case EK_RES: epilogue<EK_RES>(lds, E, acc, cur, wr, wc, fr_, fq_); break;
          case EK_RESO: epilogue<EK_RESO>(lds, E, acc, cur, wr, wc, fr_, fq_); break;
          case EK_RESO2: epilogue<EK_RESO2>(lds, E, acc, cur, wr, wc, fr_, fq_); break;
          case EK_RES2: epilogue<EK_RES2>(lds, E, acc, cur, wr, wc, fr_, fq_); break;
          case EK_GLU: epilogue<EK_GLU>(lds, E, acc, cur, wr, wc, fr_, fq_); break;
          case EK_LRUIN: epilogue<EK_LRUIN>(lds, E, acc, cur, wr, wc, fr_, fq_); break;
          default: epilogue<EK_QKV>(lds, E, acc, cur, wr, wc, fr_, fq_); break;
          } }
        asm volatile("s_waitcnt vmcnt(0)" ::: "memory");
        if (type != T_IN && (tid_now(F.wave) & 63) == 0) (void)__hip_atomic_fetch_add(c.cnt + ((c.l * 3 + type) * 72 + pm) * 16, 1u, __ATOMIC_RELAXED, __HIP_MEMORY_SCOPE_AGENT);
        if (c.l == 3 && type == T_OUT && (tid_now(F.wave) & 63) == 0) (void)__hip_atomic_fetch_add(c.cnt + (14 * 72 + c.x) * 16, 1u, __ATOMIC_RELAXED, __HIP_MEMORY_SCOPE_AGENT);
        if (!stream_on) { ret = npos < c.nlist ? npos : END; break; }
        if (tid_now(F.wave) == 0) MISC[MB_NEXT] = nposv;
#pragma unroll
        for (int a = 0; a < 2; ++a)
#pragma unroll
            for (int b = 0; b < 2; ++b)
#pragma unroll
                for (int m = 0; m < 4; ++m)
#pragma unroll
                    for (int n = 0; n < 2; ++n) acc[a][b][m][n] = (f32x4){0.f, 0.f, 0.f, 0.f};
        pm = npm; pn = npn; type = ntype; cA = nA; cB = nB; Kc = Kn;
        if (wr == 1) PG8_BAR;
    }
    PG8_WAIT_V(0);
    PG8_BAR;
#undef PG8_SA
#undef PG8_SB
#undef CH_STAGE_A
#undef CH_STAGE_B
#undef CH_VOFF
#undef PG8_LDA
#undef PG8_LDB
#undef PG8_MMA
#undef PG8_WAIT_V
#undef PG8_WAIT_L
#undef PG8_BAR
#undef PG8_SCHED
    return ret;
}
__device__ __forceinline__ void chain_phase(const Args& A, const Frame& F, int l, volatile LAS unsigned* MISC, int seg = -1) {
    Ctx c; c.l = l; c.P = l == 3 ? 8 : 9; c.nin = l == 3 ? 0 : 8; c.qkv3 = l == 2; c.x = (int)(xb_xcc_id() & 7u);
    if (c.qkv3) c.nin = 6;
    c.nlist = 24 * c.P + (l == 3 ? 0 : c.qkv3 ? 50 : 8 * c.P);
    c.pos0 = 0; c.nodeps = 0;
    if (seg == 1) { c.pos0 = 4 * c.P; c.nlist = 20 * c.P; c.nodeps = 1; }
    unsigned* ctl = (unsigned*)(F.ws + OFF_CTL);
    c.head = ctl + Q_OFF_WORDS + (l * 8 + c.x) * 64; c.cnt = ctl + C_OFF_WORDS;
    int pend = -1; bool in_seen = false;
    for (;;) {
        int pos = pend;
        if (pos < 0) {
            if (tid_now(F.wave) == 0) MISC[MB_POS] = c.pos0 + __hip_atomic_fetch_add(c.head, 1u, __ATOMIC_RELAXED, __HIP_MEMORY_SCOPE_AGENT);
            __syncthreads(); pos = __builtin_amdgcn_readfirstlane((int)MISC[MB_POS]); __syncthreads();
        }
        if (pos >= c.nlist) break;
        { int ty, p_, q_; decode(c, pos, ty, p_, q_); unsigned need; unsigned* dw = dep_word(c, ty, p_, need);
          if (F.wave == 0 && need) { unsigned sp = 0;
              while ((unsigned)__builtin_amdgcn_readfirstlane((int)__hip_atomic_load(dw, __ATOMIC_RELAXED, __HIP_MEMORY_SCOPE_AGENT)) < need) { __builtin_amdgcn_s_sleep(4); if (++sp > (1u << 22)) break; } }
          __syncthreads(); }
        if (pos >= 24 * c.P && !in_seen) { in_seen = true; asm volatile("s_waitcnt vmcnt(0)\n\tbuffer_inv sc0\n\ts_waitcnt vmcnt(0)" ::: "memory"); __syncthreads(); }
        if (tid_now(F.wave) == 0) MISC[MB_NEXT] = c.pos0 + __hip_atomic_fetch_add(c.head, 1u, __ATOMIC_RELAXED, __HIP_MEMORY_SCOPE_AGENT);
        __syncthreads();
        pend = stream(A, F, c, F.lds, MISC, pos);
        if (pend == END) break;
    }
    __syncthreads();
}
}
__global__ void __launch_bounds__(NTHR, 2) mk_fwd(Args A) {
    extern __shared__ __attribute__((aligned(16))) unsigned char lds_raw[];
    Frame F;
    F.lds = (LAS unsigned char*)lds_raw; F.out = A.out; F.ws = A.ws;
    F.tid = threadIdx.x; F.lane = F.tid & 63; F.wave = __builtin_amdgcn_readfirstlane(F.tid >> 6);
    F.G = gridDim.x; { const int bx = blockIdx.x; F.vcu = (F.G % 8 == 0) ? (bx % 8) * (F.G / 8) + bx / 8 : bx; }
    F.aff = 0; F.xx = 0; F.xr = 0; F.xn = 1;
    volatile LAS unsigned* MISC = (volatile LAS unsigned*)(F.lds + LDSCTL_OFF);
    if (threadIdx.x < 16) MISC[threadIdx.x] = 0u;
    __syncthreads();
    XcdBarrier bar = xcd_barrier_post((unsigned*)(GAS unsigned*)(A.ws + OFF_CTL + 16384), MISC + 8);
    const bool chain_req = MK_CHAIN && A.ph_lo == 0 && A.ph_hi == N_PHASES;
    int wv0 = __builtin_amdgcn_readfirstlane((int)threadIdx.x >> 6);
#define FTID() do { const int t_ = tid_now(F.wave); F.tid = t_; F.lane = t_ & 63; } while (0)
#define FRESH() do { int wv_ = wv0; asm volatile("" : "+s"(wv_)); F.wave = wv_; F.tid = 0; F.lane = 0; \
          KArgs ka = (KArgs)__builtin_amdgcn_kernarg_segment_ptr(); asm volatile("" : "+s"(ka)); F.ka = ka; \
          unsigned long long w = (unsigned long long)ka->ws, o = (unsigned long long)ka->out; \
          F.ws = (unsigned char*)(GAS unsigned char*)w; F.out = (float*)(GAS float*)o; \
          int gg = gridDim.x, bx = blockIdx.x; asm volatile("" : "+s"(gg), "+s"(bx)); F.G = gg; F.vcu = (gg % 8 == 0) ? (bx % 8) * (gg / 8) + bx / 8 : bx; F.bx = bx; \
          int af_ = aff_all; asm volatile("" : "+s"(af_)); F.aff = af_; F.xx = (int)(xb_xcc_id() & 7u); int xr_ = xr_all, xn_ = xn_all; asm volatile("" : "+s"(xr_), "+s"(xn_)); F.xr = xr_; F.xn = xn_; } while (0)
    int aff_all = 0, xr_all = 0, xn_all = 1;
    if (A.ph_lo <= PH_PRO0 && PH_PRO0 < A.ph_hi) { FRESH(); FTID(); phase_pro0(A, F); if (PH_PRO0 + 1 < A.ph_hi) xcd_barrier(bar, tid_now(F.wave)); }
    if (A.ph_lo <= PH_PRO1 && PH_PRO1 < A.ph_hi) { FRESH(); FTID(); phase_pro1(A, F); if (PH_PRO1 + 1 < A.ph_hi) xcd_barrier(bar, tid_now(F.wave)); }
    if (MK_AFFINE && chain_req) {
        bool ok = true;
        { unsigned* bw = (unsigned*)(GAS unsigned*)(A.ws + OFF_CTL + 16384);
#pragma unroll
          for (int j = 0; j < 16; ++j) { const unsigned cn = xb_ld(&bw[XB_XCNT(j)]); ok = ok && ((j < 8) ? (cn > 0u) : (cn == 0u)); } }
        aff_all = __builtin_amdgcn_readfirstlane(ok ? 1 : 0);
        xr_all = __builtin_amdgcn_readfirstlane((int)MISC[12]); xn_all = __builtin_amdgcn_readfirstlane((int)MISC[8]); if (xn_all < 1) xn_all = 1;
    }
#define PH_BARRIER() do { if (F.aff) xcd_local_barrier(bar, tid_now(F.wave)); else xcd_barrier(bar, tid_now(F.wave)); } while (0)
    for (int ph = A.ph_lo < PH_L0 ? PH_L0 : A.ph_lo; ph < A.ph_hi; ++ph) {
        FRESH();
        const int q = ph - PH_L0;
        int l, s;
        if (q < 5) { l = 0; s = q; } else if (q < 10) { l = 1; s = q - 5; } else if (q < 16) { l = 2; s = q - 10; } else { l = 3; s = q - 16; }
        const int st = stage_of(l, s);
#ifdef PROBE_UPCHAIN
        if (st == ST_UP && A.ph_lo == 0 && A.ph_hi == N_PHASES) { chain::chain_phase(A, F, l, MISC, 1); if (ph + 1 < A.ph_hi) PH_BARRIER(); continue; }
#endif
        if (chain_req && st == ST_OUT) {
            bool ok = true;
            { unsigned* bw = (unsigned*)(F.ws + OFF_CTL + 16384);
#pragma unroll
              for (int j = 0; j < 16; ++j) { const unsigned cn = xb_ld(&bw[XB_XCNT(j)]); ok = ok && ((j < 8) ? (cn > 0u) : (cn == 0u)); } }
            if (ok) { chain::chain_phase(A, F, l, MISC); ph += (l < 3 ? 3 : 2); if (ph + 1 < A.ph_hi) PH_BARRIER(); continue; }
        }
        pg8::Gemm g{}; pg8::Sched S{}; pg8::Epi E{};
        const int ek = gemm_descs(A, F, l, st, g, S, E);
        switch (ek) {
        case pg8::EK_MLP1: pg8::gemm_phase<pg8::EK_MLP1>(F.lds, tid_now(F.wave), g, S, E); break;
        case pg8::EK_RES: pg8::gemm_phase<pg8::EK_RES>(F.lds, tid_now(F.wave), g, S, E); break;
        case pg8::EK_RESO: pg8::gemm_phase<pg8::EK_RESO>(F.lds, tid_now(F.wave), g, S, E); break;
        case pg8::EK_RESO2: pg8::gemm_phase<pg8::EK_RESO2>(F.lds, tid_now(F.wave), g, S, E); break;
        case pg8::EK_RES2: pg8::gemm_phase<pg8::EK_RES2>(F.lds, tid_now(F.wave), g, S, E); break;
        case pg8::EK_GLU: pg8::gemm_phase<pg8::EK_GLU>(F.lds, tid_now(F.wave), g, S, E); break;
        case pg8::EK_LRUIN: pg8::gemm_phase<pg8::EK_LRUIN>(F.lds, tid_now(F.wave), g, S, E); break;
        case pg8::EK_QKV: pg8::gemm_phase<pg8::EK_QKV>(F.lds, tid_now(F.wave), g, S, E); break;
        default: break;
        }
#ifdef PROBE_DUP
        if (st == PROBE_DUP) {
            switch (ek) {
            case pg8::EK_MLP1: pg8::gemm_phase<pg8::EK_MLP1>(F.lds, tid_now(F.wave), g, S, E); break;
            case pg8::EK_GLU: pg8::gemm_phase<pg8::EK_GLU>(F.lds, tid_now(F.wave), g, S, E); break;
            case pg8::EK_LRUIN: pg8::gemm_phase<pg8::EK_LRUIN>(F.lds, tid_now(F.wave), g, S, E); break;
            case pg8::EK_QKV: pg8::gemm_phase<pg8::EK_QKV>(F.lds, tid_now(F.wave), g, S, E); break;
            default: break;
            }
            if (st == ST_ATT) { FTID(); attn_phase(F, (char*)lds_raw, l == 3); }
            else if (st == ST_CONV) { FTID(); conv31_phase(A, F); }
            else if (st == ST_CONV4) { FTID(); conv4_phase(A, F); }
            else if (st == ST_SCAN) { FTID(); lru_phase(F); }
            xcd_barrier(bar, tid_now(F.wave));
        }
#endif
        if (st == ST_ATT) { FTID(); attn_phase(F, (char*)lds_raw, l == 3); }
        else if (st == ST_CONV) { FTID(); conv31_phase(A, F); }
        else if (st == ST_CONV4) { FTID(); conv4_phase(A, F); }
        else if (st == ST_SCAN) { FTID(); lru_phase(F); }
        if (ph + 1 < A.ph_hi) PH_BARRIER();
    }
#undef FRESH
#undef FTID
}
__global__ void k_xg(XPtr X, const float* GAINt  , bf16_t* XG, float* SSQ) {
    __shared__ float red[4];
    const int row = blockIdx.x, tid = threadIdx.x, bi = row_bidx(row);
    const float4 v = ((const float4*)X.row(row))[tid];
    const float ss = block_sum256(v.x * v.x + v.y * v.y + v.z * v.z + v.w * v.w, red);
    const float4 g = ((const float4*)(GAINt + (size_t)bi * D))[tid];
    bf16_t* o = XG + (size_t)row * D + tid * 4;
    o[0] = f2bf(v.x * g.x); o[1] = f2bf(v.y * g.y); o[2] = f2bf(v.z * g.z); o[3] = f2bf(v.w * g.w);
    if (tid < 16) SSQ[(size_t)row * 16 + tid] = tid == 0 ? ss : 0.f;
}

template <typename AT, class EPI>
static void gemm(hipStream_t st, const AT* A, int lda, const float* W, int ldw, int Mr, int N, int K, EPI e) {
    hipLaunchKernelGGL((naive_gemm<AT, EPI>), dim3(N / 64, Mr / 64), dim3(256), 0, st, A, lda, W, ldw, K, e);
}
#ifndef MK_CHAIN
#define MK_CHAIN 1
#endif
#ifndef MK_N_LAUNCHES
#define MK_N_LAUNCHES 1
#endif
static int g_grid = 0;
static void fast(hipStream_t st, void* const* d_in, void* d_out, void* d_ws, int lo, int hi) {
    Args a{}; for (int i = 0; i < 29; ++i) a.in[i] = (const float*)d_in[i];
    a.out = (float*)d_out; a.ws = (unsigned char*)d_ws; a.ph_lo = lo; a.ph_hi = hi;
    hipLaunchKernelGGL(mk_fwd, dim3(g_grid), dim3(NTHR), LDS_BYTES, st, a);
}
extern "C" void kernel_launch(void* const* d_in, const int* in_sizes, int n_in, void* d_out, int out_size, void* d_ws, size_t ws_size, hipStream_t stream) {
    if (n_in != 29 || out_size != ML * D || ws_size < WS_END) { fprintf(stderr, "kernel_launch: unexpected shapes (n_in %d out %d ws %zu)\n", n_in, out_size, ws_size); return; }
    if (g_grid == 0) {
        int dev = 0, cus = 0, per_cu = 0;
        if (hipGetDevice(&dev) != hipSuccess || hipDeviceGetAttribute(&cus, hipDeviceAttributeMultiprocessorCount, dev) != hipSuccess) { fprintf(stderr, "kernel_launch: device query failed\n"); g_grid = -1; return; }
        if (hipFuncSetAttribute((const void*)mk_fwd, hipFuncAttributeMaxDynamicSharedMemorySize, LDS_BYTES) != hipSuccess) { fprintf(stderr, "kernel_launch: hipFuncSetAttribute failed\n"); g_grid = -1; return; }
        if (hipOccupancyMaxActiveBlocksPerMultiprocessor(&per_cu, (const void*)mk_fwd, NTHR, LDS_BYTES) != hipSuccess || per_cu < 1) { fprintf(stderr, "kernel_launch: occupancy query says %d blocks per CU\n", per_cu); (void)hipGetLastError(); }
        g_grid = cus;
    }
    if (g_grid < 0) return;
    (void)in_sizes;
    (void)hipMemsetAsync((unsigned char*)d_ws + OFF_CTL, 0, 1 * MiB, stream);
#ifdef PROBE_K
    fast(stream, d_in, d_out, d_ws, 0, PROBE_K);
    (void)hipMemsetAsync((unsigned char*)d_ws + OFF_CTL, 0, 1 * MiB, stream);
#endif
    if (MK_N_LAUNCHES == 1) fast(stream, d_in, d_out, d_ws, 0, N_PHASES);
    else for (int p = 0; p < N_PHASES; ++p) fast(stream, d_in, d_out, d_ws, p, p + 1);
}
```
